# Optimizing an MI355X kernel written in HIP

```python
import jax, jax.numpy as jnp
from jax import lax
import numpy as np

D_MODEL = 1024
BATCH = 32
SEQ = 2048
DEPTH = 1

PLE_DIM = 256
HEAD_DIM = 64
MOBA_HEADS = 8
MOBA_BLOCK = 256
MOBA_TOPK = 3
MOBA_Q_CHUNK = 16
DIFF_HEADS = 4
DIFF_V_DIM = 2 * HEAD_DIM
ROPE_THETA = 500000.0
ROPE_DIM = HEAD_DIM // 4
DENSE_Q_BLOCK = 128
EPS = 1e-6
MOBA_W = MOBA_HEADS * HEAD_DIM
DIFF_QK_W = DIFF_HEADS * 2 * HEAD_DIM
DIFF_W = DIFF_HEADS * DIFF_V_DIM
MIX_W = MOBA_W + DIFF_W
SPLIT_SIZES = (MOBA_W, MOBA_W, MOBA_W, DIFF_QK_W, DIFF_QK_W, DIFF_W, MIX_W)
PROJ_W = sum(SPLIT_SIZES)

kernel_name = "hybrid_moba_diffattn_gated_ple"


def rmsnorm(x, g):
    xf = x.astype(jnp.float32)
    xf = xf * lax.rsqrt(jnp.mean(xf * xf, axis=-1, keepdims=True) + EPS)
    return (xf * g.astype(jnp.float32)).astype(x.dtype)


def rope_tables(seq):
    inv = ROPE_THETA ** (-jnp.arange(0, ROPE_DIM, 2, dtype=jnp.float32) / ROPE_DIM)
    ang = jnp.arange(seq, dtype=jnp.float32)[:, None] * inv[None, :]
    return jnp.cos(ang), jnp.sin(ang)


def partial_rope(x, cos, sin):
    half = ROPE_DIM // 2
    x1, x2, rest = x[..., :half], x[..., half:ROPE_DIM], x[..., ROPE_DIM:]
    c, s = cos.astype(x.dtype), sin.astype(x.dtype)
    return jnp.concatenate([x1 * c - x2 * s, x2 * c + x1 * s, rest], axis=-1)


def moba_attention(q, k, v, cos, sin):
    B, H, S, dh = q.shape
    q = partial_rope(q, cos, sin)
    k = partial_rope(k, cos, sin)
    nb = -(-S // MOBA_BLOCK)
    pad = nb * MOBA_BLOCK - S
    kp = jnp.pad(k, ((0, 0), (0, 0), (0, pad), (0, 0)))
    vp = jnp.pad(v, ((0, 0), (0, 0), (0, pad), (0, 0)))
    kb = kp.reshape(B, H, nb, MOBA_BLOCK, dh)
    vb = vp.reshape(B, H, nb, MOBA_BLOCK, dh)
    kmean = jnp.mean(kb.astype(jnp.float32), axis=3)
    n_sel = min(MOBA_TOPK, nb)
    scale = dh ** -0.5
    bi = jnp.arange(B)[:, None, None, None]
    hi = jnp.arange(H)[None, :, None, None]
    blk_ids = jnp.arange(nb)
    key_off = jnp.arange(MOBA_BLOCK)

    def chunk(c):
        start = c * MOBA_Q_CHUNK
        qc = lax.dynamic_slice_in_dim(q, start, MOBA_Q_CHUNK, axis=2)
        qpos = start + jnp.arange(MOBA_Q_CHUNK)
        own = start // MOBA_BLOCK
        gate = jnp.einsum('bhqd,bhnd->bhqn', qc.astype(jnp.float32), kmean)
        gate = jnp.where(blk_ids < own, gate, -jnp.inf)
        _, sel = lax.top_k(gate, n_sel)
        sel_ok = sel < own
        ks = kb[bi, hi, sel]
        vs = vb[bi, hi, sel]
        s_sel = jnp.einsum('bhqd,bhqnkd->bhqnk', qc, ks).astype(jnp.float32) * scale
        s_sel = jnp.where(sel_ok[..., None], s_sel, -jnp.inf)
        s_sel = s_sel.reshape(B, H, MOBA_Q_CHUNK, n_sel * MOBA_BLOCK)
        ko = lax.dynamic_slice_in_dim(kp, own * MOBA_BLOCK, MOBA_BLOCK, axis=2)
        vo = lax.dynamic_slice_in_dim(vp, own * MOBA_BLOCK, MOBA_BLOCK, axis=2)
        kpos = own * MOBA_BLOCK + key_off
        s_own = jnp.einsum('bhqd,bhkd->bhqk', qc, ko).astype(jnp.float32) * scale
        s_own = jnp.where(kpos[None, :] <= qpos[:, None], s_own, -jnp.inf)
        probs = jax.nn.softmax(jnp.concatenate([s_sel, s_own], axis=-1), axis=-1).astype(v.dtype)
        p_sel = probs[..., :n_sel * MOBA_BLOCK].reshape(B, H, MOBA_Q_CHUNK, n_sel, MOBA_BLOCK)
        p_own = probs[..., n_sel * MOBA_BLOCK:]
        return (jnp.einsum('bhqnk,bhqnkd->bhqd', p_sel, vs)
                + jnp.einsum('bhqk,bhkd->bhqd', p_own, vo))

    outs = lax.map(chunk, jnp.arange(S // MOBA_Q_CHUNK))
    return outs.transpose(1, 2, 0, 3, 4).reshape(B, H, S, dh)


def diff_attention(q, k, v, lam, g_subln, lambda_init, cos, sin):
    B, H, _, S, dh = q.shape
    q = partial_rope(q, cos, sin)
    k = partial_rope(k, cos, sin)
    scale = dh ** -0.5
    kpos = jnp.arange(S)

    def block(c):
        start = c * DENSE_Q_BLOCK
        qc = lax.dynamic_slice_in_dim(q, start, DENSE_Q_BLOCK, axis=3)
        s = jnp.einsum('bhiqd,bhikd->bhiqk', qc, k).astype(jnp.float32) * scale
        qpos = start + jnp.arange(DENSE_Q_BLOCK)
        s = jnp.where(kpos[None, :] <= qpos[:, None], s, -jnp.inf)
        pr = jax.nn.softmax(s, axis=-1)
        a = pr[:, :, 0] - lam * pr[:, :, 1]
        return jnp.einsum('bhqk,bhkd->bhqd', a.astype(v.dtype), v)

    o = lax.map(block, jnp.arange(S // DENSE_Q_BLOCK))
    o = o.transpose(1, 2, 0, 3, 4).reshape(B, H, S, 2 * dh)
    return rmsnorm(o, g_subln) * (1.0 - lambda_init)


def setup_inputs(seed: int = 0) -> dict:
    key = jax.random.key(seed)
    ks = jax.random.split(key, 14)
    f32 = jnp.float32
    nrm = lambda k, shape, s: jax.random.normal(k, shape, f32) * s
    return {
        "x": nrm(ks[0], (BATCH, SEQ, D_MODEL), 1.0),
        "p": nrm(ks[1], (DEPTH, BATCH, SEQ, PLE_DIM), 1.0),
        "w_in": nrm(ks[2], (DEPTH, D_MODEL, PROJ_W), D_MODEL ** -0.5),
        "w_out": nrm(ks[3], (DEPTH, MIX_W, D_MODEL), MIX_W ** -0.5),
        "g_mix": 1.0 + nrm(ks[4], (DEPTH, D_MODEL), 0.02),
        "diff_lq1": nrm(ks[5], (DEPTH, HEAD_DIM), 0.1),
        "diff_lk1": nrm(ks[6], (DEPTH, HEAD_DIM), 0.1),
        "diff_lq2": nrm(ks[7], (DEPTH, HEAD_DIM), 0.1),
        "diff_lk2": nrm(ks[8], (DEPTH, HEAD_DIM), 0.1),
        "g_subln": 1.0 + nrm(ks[9], (DEPTH, DIFF_V_DIM), 0.02),
        "w_ple": nrm(ks[10], (DEPTH, PLE_DIM, D_MODEL), PLE_DIM ** -0.5),
        "w_ple_gate": nrm(ks[11], (DEPTH, D_MODEL, D_MODEL), D_MODEL ** -0.5),
        "g_ple": 1.0 + nrm(ks[12], (DEPTH, D_MODEL), 0.02),
        "g_final": 1.0 + nrm(ks[13], (D_MODEL,), 0.02),
    }


def reference(x, p, w_in, w_out, g_mix, diff_lq1, diff_lk1, diff_lq2, diff_lk2,
              g_subln, w_ple, w_ple_gate, g_ple, g_final):
    B, S, _ = x.shape
    cos, sin = rope_tables(S)
    offsets = [int(o) for o in np.cumsum(SPLIT_SIZES)[:-1]]
    h = x
    for i in range(DEPTH):
        lambda_init = 0.8 - 0.6 * float(np.exp(-0.3 * i))
        u = rmsnorm(h, g_mix[i])
        proj = jnp.einsum('bsd,de->bse', u, w_in[i])
        mq, mk, mv, dq, dk, dv, z = jnp.split(proj, offsets, axis=-1)
        to_heads = lambda t: t.reshape(B, S, MOBA_HEADS, HEAD_DIM).transpose(0, 2, 1, 3)
        m_out = moba_attention(to_heads(mq), to_heads(mk), to_heads(mv), cos, sin)
        m_out = m_out.transpose(0, 2, 1, 3).reshape(B, S, MOBA_W)
        dq = dq.reshape(B, S, DIFF_HEADS, 2, HEAD_DIM).transpose(0, 2, 3, 1, 4)
        dk = dk.reshape(B, S, DIFF_HEADS, 2, HEAD_DIM).transpose(0, 2, 3, 1, 4)
        dv = dv.reshape(B, S, DIFF_HEADS, DIFF_V_DIM).transpose(0, 2, 1, 3)
        lam = (jnp.exp(jnp.sum(diff_lq1[i].astype(jnp.float32) * diff_lk1[i].astype(jnp.float32)))
               - jnp.exp(jnp.sum(diff_lq2[i].astype(jnp.float32) * diff_lk2[i].astype(jnp.float32)))
               + lambda_init)
        d_out = diff_attention(dq, dk, dv, lam, g_subln[i], lambda_init, cos, sin)
        d_out = d_out.transpose(0, 2, 1, 3).reshape(B, S, DIFF_W)
        y = jnp.concatenate([m_out, d_out], axis=-1) * jax.nn.silu(z)
        h = h + jnp.einsum('bse,ed->bsd', y, w_out[i])
        pe = jnp.einsum('bsk,kd->bsd', p[i], w_ple[i])
        gate = jax.nn.sigmoid(jnp.einsum('bsd,de->bse', rmsnorm(h, g_ple[i]), w_ple_gate[i]))
        h = h + gate * pe
    return rmsnorm(h, g_final)
```

```cpp
#include <hip/hip_runtime.h>
#include <hip/hip_cooperative_groups.h>
#include <cstdio>
#include <cstdint>
namespace cg = cooperative_groups;
namespace pg8 {
#define PG8_LAS __attribute__((address_space(3)))
typedef unsigned short bf16_t;
typedef short bf16x8 __attribute__((ext_vector_type(8)));
typedef float f32x4 __attribute__((ext_vector_type(4)));
typedef unsigned u32x4 __attribute__((ext_vector_type(4)));
constexpr int BM = 256, BK = 64, HALF = 128, HTB = HALF * BK * 2  , STAGE_BYTES = 8 * HTB, NXCD = 8, WGM = 8;

__host__ __device__ __forceinline__ int lds_byte(int r, int c) { const int st = (r >> 4) * 2 + (c >> 5), rr = r & 15, cc = c & 31, ob = rr * 64 + cc * 2; return st * 1024 + (ob ^ (((ob >> 9) & 1) << 5)); }
__host__ __device__ __forceinline__ void stage_rc(int b, int& R, int& C) { const int st = b / 1024, sb = b % 1024, swz = sb ^ (((sb >> 9) & 1) << 5); R = (st >> 1) * 16 + swz / 64; C = (st & 1) * 32 + (swz % 64) / 2; }
__host__ __device__ __forceinline__ int perm32(int rho) { const int n = rho >> 4, i = rho & 15; return 8 * (i >> 2) + 4 * n + (i & 3); }

struct Unit { int pm, pn; };
struct Gemm { const bf16_t* A; const bf16_t* Bt; int M, N, K; };

struct StaticOrder {
    int nM, nN, nwg, G, c;
    __host__ __device__ void init(int M, int N, int G_, int c_) { nM = M / BM; nN = N / BM; nwg = nM * nN; G = G_; c = c_; }
    __host__ __device__ bool next(int i, Unit& u) const {
        const long L = (long)i * G + c; if (L >= nwg) return false;
        int wgid = (int)L; { const int q = nwg / NXCD, r = nwg % NXCD, xcd = wgid % NXCD, off = wgid / NXCD; wgid = (xcd < r ? xcd * (q + 1) : r * (q + 1) + (xcd - r) * q) + off; }
        const int nig = WGM * nN, gid = wgid / nig, fm = gid * WGM, gsz = (nM - fm) < WGM ? (nM - fm) : WGM;
        u.pm = fm + ((wgid % nig) % gsz); u.pn = (wgid % nig) / gsz; return true;
    }
    __device__ __forceinline__ void a_ready(const Unit&) const {}
    __device__ __forceinline__ void done(const Unit&) const {}
};

__device__ __forceinline__ unsigned cvt_pk_bf16(float lo, float hi) { unsigned r; asm volatile("v_cvt_pk_bf16_f32 %0, %1, %2" : "=v"(r) : "v"(lo), "v"(hi)); return r; }
typedef float f32x2 __attribute__((ext_vector_type(2)));
__device__ __forceinline__ f32x2 gelu_pk(f32x2 v) {
    const f32x2 av = __builtin_elementwise_abs(v), d = av * 0.2316418882f + 1.0f;
    f32x2 t; t.x = __builtin_amdgcn_rcpf(d.x); t.y = __builtin_amdgcn_rcpf(d.y);
    f32x2 q = t * 0.5307027145f + (-0.7265760135f); q = q * t + 0.7107068705f; q = q * t + (-0.142248368f); q = q * t + 0.127414796f; q = q * t;
    const f32x2 s = (v * v) * (-0.72134752044f);
    f32x2 e; e.x = __builtin_amdgcn_exp2f(s.x); e.y = __builtin_amdgcn_exp2f(s.y);
    const f32x2 m = v * (q * e), r = v - m;
    f32x2 o; o.x = v.x < 0.f ? m.x : r.x; o.y = v.y < 0.f ? m.y : r.y; return o;
}

template <int ACT  > struct EpiBf16 {
    static constexpr bool PERM = true, AFTER_DRAIN = false; static_assert(ACT == 0 || ACT == 1, "EpiBf16: ACT is 0 (none) or 1 (gelu_pk)");
    bf16_t* O; int ldc; const float* bias; int split_cols; size_t split_stride; float scale0;
    __device__ __forceinline__ void operator()(const f32x4 (&acc)[2][2][4][2], const Unit& u, int wr, int wc, int fr, int fq) const {
        const int row0 = u.pm * BM + wr * 64 + fr; int colt = u.pn * BM; bf16_t* base = O;
        float sc = 1.f; if (split_cols) { const int t = colt / split_cols; base += (size_t)t * split_stride; colt -= t * split_cols; if (t == 0) sc = scale0; }
        const int col0 = colt + wc * 32 + 8 * fq, bcol0 = u.pn * BM + wc * 32 + 8 * fq;
        f32x4 bv[2][2];
#pragma unroll
        for (int bj = 0; bj < 2; ++bj)
#pragma unroll
            for (int n = 0; n < 2; ++n) bv[bj][n] = bias ? *(const f32x4*)(bias + bcol0 + bj * HALF + 4 * n) : (f32x4){0.f, 0.f, 0.f, 0.f};
#pragma unroll
        for (int ai = 0; ai < 2; ++ai)
#pragma unroll
            for (int m = 0; m < 4; ++m) { bf16_t* rowp = base + (size_t)(row0 + ai * HALF + m * 16) * ldc + col0;
#pragma unroll
                for (int bj = 0; bj < 2; ++bj) { f32x4 v0 = acc[ai][bj][m][0] + bv[bj][0], v1 = acc[ai][bj][m][1] + bv[bj][1];
                    if (ACT == 1) { f32x2 a = gelu_pk((f32x2){v0[0], v0[1]}), b = gelu_pk((f32x2){v0[2], v0[3]}), c = gelu_pk((f32x2){v1[0], v1[1]}), d = gelu_pk((f32x2){v1[2], v1[3]});
                        v0 = (f32x4){a.x, a.y, b.x, b.y}; v1 = (f32x4){c.x, c.y, d.x, d.y}; }
                    v0 = v0 * sc; v1 = v1 * sc; u32x4 w; w.x = cvt_pk_bf16(v0[0], v0[1]); w.y = cvt_pk_bf16(v0[2], v0[3]); w.z = cvt_pk_bf16(v1[0], v1[1]); w.w = cvt_pk_bf16(v1[2], v1[3]);
                    *(u32x4*)(rowp + bj * HALF) = w; } }
    }
};
constexpr float QC2 = 0.125f * 1.4426950408889634f;
struct EpiProj {
    static constexpr bool PERM = true, AFTER_DRAIN = false;
    bf16_t* O; bf16_t* Z; const float* rope;
    __device__ __forceinline__ void operator()(const f32x4 (&acc)[2][2][4][2], const Unit& u, int wr, int wc, int fr, int fq) const {
        const int pn = u.pn;
        const bool do_rope = (pn < 4) || (pn >= 6 && pn < 10);
        const bool is_q = (pn < 2) || (pn == 6) || (pn == 7);
        const bool do_silu = pn >= 12;
        const float sc = is_q ? QC2 : 1.f;
        const int row0 = u.pm * BM + wr * 64 + fr;
        const float sg = (fq == 0) ? -1.f : 1.f;
#pragma unroll
        for (int ai = 0; ai < 2; ++ai)
#pragma unroll
            for (int m = 0; m < 4; ++m) {
                const int row = row0 + ai * HALF + m * 16;
                bf16_t* rowp = do_silu ? Z + (size_t)row * 1024 + (pn - 12) * 256 + wc * 64 + 8 * fq : O + ((size_t)(pn * 4 + wc) * 65536 + row) * 64 + 8 * fq;
                f32x4 v0 = acc[ai][0][m][0], v1 = acc[ai][0][m][1], w0 = acc[ai][1][m][0], w1 = acc[ai][1][m][1];
                if (do_rope) {
                    f32x4 c0 = {1.f, 1.f, 1.f, 1.f}, c1 = c0, s0 = {0.f, 0.f, 0.f, 0.f}, s1 = s0;
                    if (fq < 2) { const float* rp = rope + (row & 2047) * 16; c0 = *(const f32x4*)(rp); c1 = *(const f32x4*)(rp + 4); s0 = *(const f32x4*)(rp + 8) * sg; s1 = *(const f32x4*)(rp + 12) * sg; }
                    f32x4 p0, p1;
#pragma unroll
                    for (int e = 0; e < 4; ++e) { p0[e] = __shfl_xor(v0[e], 16); p1[e] = __shfl_xor(v1[e], 16); }
                    v0 = v0 * c0 + p0 * s0; v1 = v1 * c1 + p1 * s1;
                }
                if (do_silu) {
#pragma unroll
                    for (int e = 0; e < 4; ++e) { v0[e] = v0[e] * __builtin_amdgcn_rcpf(1.f + __expf(-v0[e])); v1[e] = v1[e] * __builtin_amdgcn_rcpf(1.f + __expf(-v1[e]));
                                                  w0[e] = w0[e] * __builtin_amdgcn_rcpf(1.f + __expf(-w0[e])); w1[e] = w1[e] * __builtin_amdgcn_rcpf(1.f + __expf(-w1[e])); }
                }
                v0 = v0 * sc; v1 = v1 * sc; w0 = w0 * sc; w1 = w1 * sc;
                u32x4 a, b; a.x = cvt_pk_bf16(v0[0], v0[1]); a.y = cvt_pk_bf16(v0[2], v0[3]); a.z = cvt_pk_bf16(v1[0], v1[1]); a.w = cvt_pk_bf16(v1[2], v1[3]);
                b.x = cvt_pk_bf16(w0[0], w0[1]); b.y = cvt_pk_bf16(w0[2], w0[3]); b.z = cvt_pk_bf16(w1[0], w1[1]); b.w = cvt_pk_bf16(w1[2], w1[3]);
                __builtin_nontemporal_store(a, (u32x4*)(rowp)); __builtin_nontemporal_store(b, (u32x4*)(rowp + 32));
            }
    }
};
typedef unsigned u32x2 __attribute__((ext_vector_type(2)));
struct EpiOut {
    static constexpr bool PERM = false, AFTER_DRAIN = false;
    const float* x; bf16_t* hb; float* part;
    __device__ __forceinline__ void operator()(const f32x4 (&acc)[2][2][4][2], const Unit& u, int wr, int wc, int fr, int fq) const {
        const int col0 = u.pn * BM + wc * 32 + 4 * fq;
#pragma unroll
        for (int ai = 0; ai < 2; ++ai) {
            f32x4 xv[4][2][2];
#pragma unroll
            for (int m = 0; m < 4; ++m) { const size_t off = (size_t)(u.pm * BM + ai * HALF + wr * 64 + m * 16 + fr) * 1024 + col0;
#pragma unroll
                for (int bj = 0; bj < 2; ++bj)
#pragma unroll
                    for (int n = 0; n < 2; ++n) xv[m][bj][n] = __builtin_nontemporal_load((const f32x4*)(x + off + bj * HALF + n * 16)); }
#pragma unroll
            for (int m = 0; m < 4; ++m) {
                const int r = u.pm * BM + ai * HALF + wr * 64 + m * 16 + fr; const size_t off = (size_t)r * 1024 + col0; float ss = 0.f;
#pragma unroll
                for (int bj = 0; bj < 2; ++bj)
#pragma unroll
                    for (int n = 0; n < 2; ++n) {
                        const f32x4 h = xv[m][bj][n] + acc[ai][bj][m][n];
                        ss += (h[0] * h[0] + h[1] * h[1]) + (h[2] * h[2] + h[3] * h[3]);
                        u32x2 w; w.x = cvt_pk_bf16(h[0], h[1]); w.y = cvt_pk_bf16(h[2], h[3]);
                        *(u32x2*)(hb + off + bj * HALF + n * 16) = w;
                    }
                ss += __shfl_xor(ss, 16); ss += __shfl_xor(ss, 32);
                if (fq == 0) part[(size_t)r * 16 + u.pn * 4 + wc] = ss;
            }
            asm volatile("" ::: "memory");
        }
    }
};
struct EpiGate {
    static constexpr bool PERM = false, AFTER_DRAIN = false;
    const bf16_t* hb; const bf16_t* pe; float* out; const float* part; float* part2; unsigned* cnt; const float* gfin;
    __device__ __forceinline__ void operator()(f32x4 (&acc)[2][2][4][2], const Unit& u, int wr, int wc, int fr, int fq) const {
        const int col0 = u.pn * BM + wc * 32 + 4 * fq;
        const int rbase = u.pm * BM + wr * 64 + fr;
        float rs[8];
        { f32x4 q[8];
#pragma unroll
          for (int k = 0; k < 8; ++k) q[k] = *(const f32x4*)(part + (size_t)(rbase + (k >> 2) * HALF + (k & 3) * 16) * 16 + 4 * fq);
#pragma unroll
          for (int k = 0; k < 8; ++k) { float t = (q[k][0] + q[k][1]) + (q[k][2] + q[k][3]); t += __shfl_xor(t, 16); t += __shfl_xor(t, 32); rs[k] = __builtin_amdgcn_rsqf(t * (1.f / 1024.f) + 1e-6f); } }
#pragma unroll
        for (int kp = 0; kp < 4; ++kp) { const int ai = kp >> 1;
            u32x2 hv[2][2][2], pv[2][2][2];
#pragma unroll
            for (int mm = 0; mm < 2; ++mm) { const int m = (kp & 1) * 2 + mm; const size_t off = (size_t)(rbase + ai * HALF + m * 16) * 1024 + col0;
#pragma unroll
                for (int bj = 0; bj < 2; ++bj)
#pragma unroll
                    for (int n = 0; n < 2; ++n) { hv[mm][bj][n] = *(const u32x2*)(hb + off + bj * HALF + n * 16); pv[mm][bj][n] = *(const u32x2*)(pe + off + bj * HALF + n * 16); } }
#pragma unroll
            for (int mm = 0; mm < 2; ++mm) { const int m = (kp & 1) * 2 + mm;
#pragma unroll
                for (int bj = 0; bj < 2; ++bj)
#pragma unroll
                    for (int n = 0; n < 2; ++n) {
                        const u32x2 hw = hv[mm][bj][n], pw = pv[mm][bj][n];
                        const f32x4 h = {__uint_as_float(hw.x << 16), __uint_as_float(hw.x & 0xffff0000u), __uint_as_float(hw.y << 16), __uint_as_float(hw.y & 0xffff0000u)};
                        const f32x4 p = {__uint_as_float(pw.x << 16), __uint_as_float(pw.x & 0xffff0000u), __uint_as_float(pw.y << 16), __uint_as_float(pw.y & 0xffff0000u)};
                        const f32x4 a = acc[ai][bj][m][n] * rs[ai * 4 + m]; f32x4 o;
#pragma unroll
                        for (int e = 0; e < 4; ++e) o[e] = h[e] + p[e] * __builtin_amdgcn_rcpf(1.f + __expf(-a[e]));
                        acc[ai][bj][m][n] = o;
                    } }
            asm volatile("" ::: "memory");
        }
        { float ssv[8];
#pragma unroll
          for (int k = 0; k < 8; ++k) { const int ai = k >> 2, m = k & 3; float ss = 0.f;
#pragma unroll
            for (int bj = 0; bj < 2; ++bj)
#pragma unroll
                for (int n = 0; n < 2; ++n) { const f32x4 h = acc[ai][bj][m][n]; ss += (h[0] * h[0] + h[1] * h[1]) + (h[2] * h[2] + h[3] * h[3]); }
            ss += __shfl_xor(ss, 16); ss += __shfl_xor(ss, 32); ssv[k] = ss; }
          if (fq == 0) {
#pragma unroll
            for (int k = 0; k < 8; ++k) __hip_atomic_store(part2 + (size_t)(rbase + (k >> 2) * HALF + (k & 3) * 16) * 16 + u.pn * 4 + wc, ssv[k], __ATOMIC_RELAXED, __HIP_MEMORY_SCOPE_AGENT); } }
        asm volatile("s_waitcnt vmcnt(0)" ::: "memory");
        unsigned* c = cnt + 64 * u.pm;
        if (fr == 0 && fq == 0) __hip_atomic_fetch_add(c, 1u, __ATOMIC_RELAXED, __HIP_MEMORY_SCOPE_AGENT);
        { unsigned sp = 0;
          while ((unsigned)__builtin_amdgcn_readfirstlane(__hip_atomic_load(c, __ATOMIC_RELAXED, __HIP_MEMORY_SCOPE_AGENT)) < 32u) { __builtin_amdgcn_s_sleep(8); if (++sp > (1u << 20)) break; } }
#pragma unroll
        for (int k = 0; k < 8; ++k) { const float* pp = part2 + (size_t)(rbase + (k >> 2) * HALF + (k & 3) * 16) * 16 + 4 * fq;
            const float t0 = __hip_atomic_load(pp, __ATOMIC_RELAXED, __HIP_MEMORY_SCOPE_AGENT), t1 = __hip_atomic_load(pp + 1, __ATOMIC_RELAXED, __HIP_MEMORY_SCOPE_AGENT),
                        t2 = __hip_atomic_load(pp + 2, __ATOMIC_RELAXED, __HIP_MEMORY_SCOPE_AGENT), t3 = __hip_atomic_load(pp + 3, __ATOMIC_RELAXED, __HIP_MEMORY_SCOPE_AGENT);
            float t = (t0 + t1) + (t2 + t3); t += __shfl_xor(t, 16); t += __shfl_xor(t, 32); rs[k] = __builtin_amdgcn_rsqf(t * (1.f / 1024.f) + 1e-6f); }
        f32x4 gf[2][2];
#pragma unroll
        for (int bj = 0; bj < 2; ++bj)
#pragma unroll
            for (int n = 0; n < 2; ++n) gf[bj][n] = *(const f32x4*)(gfin + col0 + bj * HALF + n * 16);
#pragma unroll
        for (int k = 0; k < 8; ++k) { const int ai = k >> 2, m = k & 3; const size_t off = (size_t)(rbase + ai * HALF + m * 16) * 1024 + col0;
#pragma unroll
            for (int bj = 0; bj < 2; ++bj)
#pragma unroll
                for (int n = 0; n < 2; ++n) __builtin_nontemporal_store(acc[ai][bj][m][n] * rs[k] * gf[bj][n], (f32x4*)(out + off + bj * HALF + n * 16)); }
    }
};

template <class Epi, class Sched, bool ALIGN_EPI = false, bool SP2 = false>
__device__ __forceinline__ void gemm_phase(PG8_LAS unsigned char* lds, const Gemm g, const Sched& S, const Epi& E) {
    const int tid = threadIdx.x, wid = __builtin_amdgcn_readfirstlane(tid >> 6), lane = tid & 63, wr = wid >> 2, wc = wid & 3, fr = lane & 15, fq = lane >> 4;
    const int K = g.K, nt = K / BK;
    unsigned voffA[2], voffB[2];
#pragma unroll
    for (int i = 0; i < 2; ++i) { int R, C; stage_rc(tid * 16 + i * 8192, R, C); const int Rb = Epi::PERM ? ((R & ~31) + perm32(R & 31)) : R;
        voffA[i] = (unsigned)(R * K + C) * 2u; voffB[i] = (unsigned)(Rb * K + C) * 2u; }
    const size_t kstep = (size_t)(BK * 2);
    const size_t hstep = (size_t)HALF * K * 2;
    const size_t tstep = 2 * hstep;
    const unsigned ldsw = (unsigned)wid * 1024u;
    const int aoff = lds_byte(wr * 64 + fr, fq * 8), boff = lds_byte(wc * 32 + fr, fq * 8);
#define PG8_SA(b, h) (((b) * 2 + (h)) * HTB)
#define PG8_SB(b, h) ((4 + (b) * 2 + (h)) * HTB)
#define PG8_STAGE(bufoff, gbase, voff) do { _Pragma("unroll") for (int _i = 0; _i < 2; ++_i) \
        __builtin_amdgcn_global_load_lds((const unsigned*)((const char*)(gbase) + (voff)[_i]), (PG8_LAS unsigned*)(lds + (bufoff) + ldsw + _i * 8192), 16, 0, 0); } while (0)
#define PG8_LDA(dst, b, h) do { _Pragma("unroll") for (int m = 0; m < 4; ++m) _Pragma("unroll") for (int k = 0; k < 2; ++k) dst[m][k] = *(const PG8_LAS bf16x8*)(lds + PG8_SA(b, h) + aoff + m * 2048 + k * 1024); } while (0)
#define PG8_LDB(dst, b, h) do { _Pragma("unroll") for (int n = 0; n < 2; ++n) _Pragma("unroll") for (int k = 0; k < 2; ++k) dst[n][k] = *(const PG8_LAS bf16x8*)(lds + PG8_SB(b, h) + boff + n * 2048 + k * 1024); } while (0)
#define PG8_MMA(ai, bj, At, Bt) do { __builtin_amdgcn_s_setprio(1); _Pragma("unroll") for (int m = 0; m < 4; ++m) _Pragma("unroll") for (int n = 0; n < 2; ++n) _Pragma("unroll") for (int k = 0; k < 2; ++k) \
        acc[ai][bj][m][n] = __builtin_amdgcn_mfma_f32_16x16x32_bf16(Bt[n][k], At[m][k], acc[ai][bj][m][n], 0, 0, 0); __builtin_amdgcn_s_setprio(0); } while (0)
#define PG8_WAIT_V(n) asm volatile("s_waitcnt vmcnt(" #n ")" ::: "memory")
#define PG8_WAIT_L(n) asm volatile("s_waitcnt lgkmcnt(" #n ")" ::: "memory")
#define PG8_BAR __builtin_amdgcn_s_barrier()
#define PG8_SCHED __builtin_amdgcn_sched_barrier(0)
    Unit cur, nxt; int ui = 0;
    if (!S.next(0, cur)) return;
    f32x4 acc[2][2][4][2];
#pragma unroll
    for (int a = 0; a < 2; ++a)
#pragma unroll
        for (int b = 0; b < 2; ++b)
#pragma unroll
            for (int m = 0; m < 4; ++m)
#pragma unroll
                for (int n = 0; n < 2; ++n) acc[a][b][m][n] = (f32x4){0.f, 0.f, 0.f, 0.f};
    bf16x8 At[4][2], B0[2][2], B1[2][2];
    const char* cA = (const char*)g.A + (size_t)cur.pm * tstep; const char* cB = (const char*)g.Bt + (size_t)cur.pn * tstep;
    S.a_ready(cur);
    if constexpr (SP2) {
        PG8_STAGE(PG8_SB(0, 0), cB, voffB); PG8_STAGE(PG8_SB(0, 1), cB + hstep, voffB); PG8_STAGE(PG8_SA(0, 0), cA, voffA); PG8_STAGE(PG8_SA(0, 1), cA + hstep, voffA);
        if (wr == 1) PG8_BAR;
        PG8_WAIT_V(2); PG8_BAR;
        PG8_STAGE(PG8_SB(1, 0), cB + kstep, voffB); PG8_STAGE(PG8_SA(1, 0), cA + kstep, voffA); PG8_STAGE(PG8_SB(1, 1), cB + hstep + kstep, voffB);
        PG8_WAIT_V(6); PG8_BAR;
    } else {
        PG8_STAGE(PG8_SB(0, 0), cB, voffB); PG8_STAGE(PG8_SA(0, 0), cA, voffA); PG8_STAGE(PG8_SB(0, 1), cB + hstep, voffB); PG8_STAGE(PG8_SA(0, 1), cA + hstep, voffA);
        if (wr == 1) PG8_BAR;
        PG8_WAIT_V(4); PG8_BAR;
        PG8_STAGE(PG8_SB(1, 0), cB + kstep, voffB); PG8_STAGE(PG8_SA(1, 0), cA + kstep, voffA); PG8_STAGE(PG8_SB(1, 1), cB + hstep + kstep, voffB);
        PG8_WAIT_V(6); PG8_BAR;
    }
    for (;;) {
        const bool has_next = S.next(ui + 1, nxt);
        const char* nA = has_next ? (const char*)g.A + (size_t)nxt.pm * tstep : cA; const char* nB = has_next ? (const char*)g.Bt + (size_t)nxt.pn * tstep : cB;
        for (int t = 0; t < nt; t += 2) {
            const bool last = (t == nt - 2);
            const char* a1 = cA + (size_t)(t + 1) * kstep;
            const char* a2 = last ? nA : cA + (size_t)(t + 2) * kstep; const char* b2 = last ? nB : cB + (size_t)(t + 2) * kstep;
            const char* a3 = a2 + kstep; const char* b3 = b2 + kstep;
            if (last && has_next) S.a_ready(nxt);
            if constexpr (SP2) {
            PG8_LDB(B0, 0, 0); PG8_LDB(B1, 0, 1); PG8_SCHED; PG8_LDA(At, 0, 0); PG8_STAGE(PG8_SA(1, 1), a1 + hstep, voffA);
            PG8_WAIT_V(8); PG8_WAIT_L(0); PG8_BAR; PG8_MMA(0, 0, At, B0); PG8_MMA(0, 1, At, B1); PG8_BAR; PG8_SCHED;
            PG8_LDA(At, 0, 1); PG8_STAGE(PG8_SB(0, 0), b2, voffB); PG8_STAGE(PG8_SB(0, 1), b2 + hstep, voffB); PG8_STAGE(PG8_SA(0, 0), a2, voffA);
            PG8_WAIT_V(8); PG8_WAIT_L(0); PG8_BAR; PG8_MMA(1, 0, At, B0); PG8_MMA(1, 1, At, B1); PG8_BAR; PG8_SCHED;
            PG8_LDB(B0, 1, 0); PG8_LDB(B1, 1, 1); PG8_SCHED; PG8_LDA(At, 1, 0); PG8_STAGE(PG8_SA(0, 1), a2 + hstep, voffA);
            PG8_WAIT_V(8); PG8_WAIT_L(0); PG8_BAR; PG8_MMA(0, 0, At, B0); PG8_MMA(0, 1, At, B1); PG8_BAR; PG8_SCHED;
            PG8_LDA(At, 1, 1); PG8_STAGE(PG8_SB(1, 0), b3, voffB); PG8_STAGE(PG8_SB(1, 1), b3 + hstep, voffB); PG8_STAGE(PG8_SA(1, 0), a3, voffA);
            PG8_WAIT_V(8); PG8_WAIT_L(0); PG8_BAR; PG8_MMA(1, 0, At, B0); PG8_MMA(1, 1, At, B1); PG8_BAR; PG8_SCHED;
            } else {
            PG8_LDB(B0, 0, 0); PG8_SCHED; PG8_LDA(At, 0, 0); PG8_STAGE(PG8_SA(1, 1), a1 + hstep, voffA);
            PG8_WAIT_L(8); PG8_BAR; PG8_WAIT_L(0); PG8_MMA(0, 0, At, B0); PG8_BAR; PG8_SCHED;
            PG8_LDB(B1, 0, 1); PG8_STAGE(PG8_SB(0, 0), b2, voffB);
            PG8_BAR; PG8_WAIT_L(0); PG8_MMA(0, 1, At, B1); PG8_BAR;
            PG8_LDA(At, 0, 1); PG8_STAGE(PG8_SA(0, 0), a2, voffA);
            PG8_BAR; PG8_WAIT_L(0); PG8_MMA(1, 0, At, B0); PG8_BAR; PG8_SCHED;
            PG8_STAGE(PG8_SB(0, 1), b2 + hstep, voffB);
            PG8_WAIT_V(6); PG8_BAR; PG8_MMA(1, 1, At, B1); PG8_BAR;
            PG8_LDB(B0, 1, 0); PG8_SCHED; PG8_LDA(At, 1, 0); PG8_STAGE(PG8_SA(0, 1), a2 + hstep, voffA);
            PG8_WAIT_L(8); PG8_BAR; PG8_WAIT_L(0); PG8_MMA(0, 0, At, B0); PG8_BAR; PG8_SCHED;
            PG8_LDB(B1, 1, 1); PG8_STAGE(PG8_SB(1, 0), b3, voffB);
            PG8_BAR; PG8_WAIT_L(0); PG8_MMA(0, 1, At, B1); PG8_BAR;
            PG8_LDA(At, 1, 1); PG8_STAGE(PG8_SA(1, 0), a3, voffA);
            PG8_BAR; PG8_WAIT_L(0); PG8_MMA(1, 0, At, B0); PG8_BAR; PG8_SCHED;
            PG8_STAGE(PG8_SB(1, 1), b3 + hstep, voffB);
            PG8_WAIT_V(6); PG8_BAR; PG8_MMA(1, 1, At, B1); PG8_BAR;
            }
        }
        if constexpr (ALIGN_EPI) { if (wr == 0) PG8_BAR; }
        if constexpr (!Epi::AFTER_DRAIN) { E(acc, cur, wr, wc, fr, fq); S.done(cur); }
        if (!has_next) break;
#pragma unroll
        for (int a = 0; a < 2; ++a)
#pragma unroll
            for (int b = 0; b < 2; ++b)
#pragma unroll
                for (int m = 0; m < 4; ++m)
#pragma unroll
                    for (int n = 0; n < 2; ++n) acc[a][b][m][n] = (f32x4){0.f, 0.f, 0.f, 0.f};
        cur = nxt; cA = nA; cB = nB; ++ui;
        if constexpr (ALIGN_EPI) { if (wr == 1) PG8_BAR; }
    }
    PG8_WAIT_V(0);
    if constexpr (!ALIGN_EPI) { if (wr == 0) PG8_BAR; }
    PG8_BAR;
    if constexpr (Epi::AFTER_DRAIN) { E.fused(acc, cur, wr, wc, fr, fq, lds, wid, lane); S.done(cur); }
#undef PG8_SA
#undef PG8_SB
#undef PG8_STAGE
#undef PG8_LDA
#undef PG8_LDB
#undef PG8_MMA
#undef PG8_WAIT_V
#undef PG8_WAIT_L
#undef PG8_BAR
#undef PG8_SCHED
}
}

#ifndef PG8_SP2
#define PG8_SP2 true
#endif
#ifndef PG8_ALIGN
#define PG8_ALIGN true
#endif
#include <hip/hip_bf16.h>
#include <cmath>
namespace attn_body {
using bf16=__hip_bfloat16;
using bf16x8=__attribute__((ext_vector_type(8)))short;
using s16x4=__attribute__((ext_vector_type(4)))short;
using f32x16=__attribute__((ext_vector_type(16)))float;
using u32x4=__attribute__((ext_vector_type(4)))unsigned;
constexpr int SEQ=2048,D=64,PQ=64,MROWS=65536;
constexpr int NW=8,QBLK=32,QB=QBLK*NW,KVBLK=64,NQB=SEQ/QB;
constexpr int ATTN_UNIT_ROWS=QB;
__device__ __forceinline__ int crow(int r,int hi){return (r&3)+8*(r>>2)+4*hi;}
#define SBAR() __builtin_amdgcn_sched_barrier(0)
__device__ __forceinline__ void cmask(f32x16&p0,f32x16&p1,int jb,int qrel,int hi){
  const float NEG=-INFINITY; int d=qrel-64*jb-4*hi; asm volatile("":"+v"(d));
  #pragma unroll
  for(int r=0;r<16;++r){const int c=(r&3)+8*(r>>2); if(c>d)p0[r]=NEG; if(c+32>d)p1[r]=NEG;}
}

constexpr int NSLOT=3, SLOTB=8192;
constexpr int LDS_K=0, LDS_V=NSLOT*SLOTB, LDS_WS=3*NSLOT*SLOTB  , LDS_OST=LDS_WS+NW*64*4, LDS_BYTES=LDS_OST+NW*4096;
constexpr float C2=0.125f*1.4426950408889634f;
__device__ __forceinline__ void glds16(const void*gsrc,unsigned lds_dst){unsigned keep;
  asm volatile("s_mov_b32 %0, m0\n\ts_mov_b32 m0, %2\n\ts_nop 0\n\tglobal_load_lds_dwordx4 %1, off\n\ts_mov_b32 m0, %0":"=&s"(keep):"v"(gsrc),"s"(lds_dst):"memory");}
__device__ __forceinline__ void glds16s(const void*sbase,unsigned voff,unsigned lds_dst){unsigned keep;
  asm volatile("s_mov_b32 %0, m0\n\ts_mov_b32 m0, %2\n\ts_nop 0\n\tglobal_load_lds_dwordx4 %1, %3\n\ts_mov_b32 m0, %0":"=&s"(keep):"v"(voff),"s"(lds_dst),"s"(sbase):"memory");}
__device__ __forceinline__ float max3f(float a,float b,float c){float r;asm("v_max3_f32 %0, %1, %2, %3":"=v"(r):"v"(a),"v"(b),"v"(c));return r;}
__device__ __forceinline__ float max2f(float a,float b){float r;asm("v_max_f32_e32 %0, %1, %2":"=v"(r):"v"(a),"v"(b));return r;}
__device__ __forceinline__ float fadd_s(float a,float b){float r;asm("v_add_f32_e32 %0, %1, %2":"=v"(r):"v"(a),"v"(b));return r;}
__device__ __forceinline__ float fsub_s(float a,float b){float r;asm("v_sub_f32_e32 %0, %1, %2":"=v"(r):"v"(a),"v"(b));return r;}
typedef float f32x4_t __attribute__((ext_vector_type(4))); typedef float f32x2_t __attribute__((ext_vector_type(2))); typedef __bf16 bf16x2_t __attribute__((ext_vector_type(2)));
__device__ __forceinline__ unsigned cvtpk_s(float lo,float hi){f32x2_t v={lo,hi};bf16x2_t b=__builtin_convertvector(v,bf16x2_t);return __builtin_bit_cast(unsigned,b);}
#define WAIT_BAR(N) asm volatile("s_waitcnt vmcnt(" #N ") lgkmcnt(0)\n\ts_barrier":::"memory")

__device__ __forceinline__ void qkt(f32x16&p0,f32x16&p1,const char*Kslot,const bf16x8*qr,const f32x16&negm,int r32,int hi){
  const char*kb=Kslot+hi*1024+r32*16;
  #pragma unroll
  for(int d0=0;d0<4;++d0){
    const bf16x8 b0=*reinterpret_cast<const bf16x8*>(kb+d0*2048);
    const bf16x8 b1=*reinterpret_cast<const bf16x8*>(kb+d0*2048+512);
    if(d0==0){p0=__builtin_amdgcn_mfma_f32_32x32x16_bf16(b0,qr[0],negm,0,0,0);p1=__builtin_amdgcn_mfma_f32_32x32x16_bf16(b1,qr[0],negm,0,0,0);}
    else{p0=__builtin_amdgcn_mfma_f32_32x32x16_bf16(b0,qr[d0],p0,0,0,0);p1=__builtin_amdgcn_mfma_f32_32x32x16_bf16(b1,qr[d0],p1,0,0,0);}}
}
typedef __attribute__((address_space(3))) const char* lds_cptr;
typedef short v4i16_t __attribute__((ext_vector_type(4)));
__device__ __forceinline__ void kload8(bf16x8*kf,lds_cptr kp){
  kf[0]=*(const __attribute__((address_space(3))) bf16x8*)(kp);      kf[1]=*(const __attribute__((address_space(3))) bf16x8*)(kp+512);
  kf[2]=*(const __attribute__((address_space(3))) bf16x8*)(kp+2048); kf[3]=*(const __attribute__((address_space(3))) bf16x8*)(kp+2560);
  kf[4]=*(const __attribute__((address_space(3))) bf16x8*)(kp+4096); kf[5]=*(const __attribute__((address_space(3))) bf16x8*)(kp+4608);
  kf[6]=*(const __attribute__((address_space(3))) bf16x8*)(kp+6144); kf[7]=*(const __attribute__((address_space(3))) bf16x8*)(kp+6656);
}
__device__ __forceinline__ void kload2(bf16x8*kf,lds_cptr kp,int j){ kf[2*j]=*(const __attribute__((address_space(3))) bf16x8*)(kp+j*2048); kf[2*j+1]=*(const __attribute__((address_space(3))) bf16x8*)(kp+j*2048+512); }
__device__ __forceinline__ s16x4 vtr(lds_cptr p){ return __builtin_bit_cast(s16x4,__builtin_amdgcn_ds_read_tr16_b64_v4i16((__attribute__((address_space(3))) v4i16_t*)p)); }
__device__ __forceinline__ float rowmax(const f32x16&p0,const f32x16&p1){
  float a=max3f(p0[0],p0[1],p1[0]),b=max3f(p0[2],p0[3],p1[1]);a=max3f(a,p1[2],p1[3]);
  #pragma unroll
  for(int r=4;r<16;r+=4){a=max3f(a,p0[r],p0[r+1]);b=max3f(b,p0[r+2],p0[r+3]);a=max3f(a,p1[r],p1[r+1]);b=max3f(b,p1[r+2],p1[r+3]);}
  const float m=max2f(a,b);
  auto rr=__builtin_amdgcn_permlane32_swap(__float_as_uint(m),__float_as_uint(m),false,false);
  return max2f(__uint_as_float(rr[0]),__uint_as_float(rr[1]));
}
__device__ __forceinline__ void pv(f32x16*o,int vb,bf16x8 pa0,bf16x8 pa1,bf16x8 pa2,bf16x8 pa3){
  #pragma unroll
  for(int d0=0;d0<2;++d0){s16x4 lo[4],hi[4];
    #pragma unroll
    for(int ks=0;ks<4;++ks){
      asm volatile("ds_read_b64_tr_b16 %0,%1 offset:%c2":"=&v"(lo[ks]):"v"(vb),"i"(d0*4096+ks*1024):"memory");
      asm volatile("ds_read_b64_tr_b16 %0,%1 offset:%c2":"=&v"(hi[ks]):"v"(vb),"i"(d0*4096+ks*1024+512):"memory");}
    asm volatile("s_waitcnt lgkmcnt(0)":::"memory");SBAR();
    #define PK(k) (bf16x8){lo[k][0],lo[k][1],lo[k][2],lo[k][3],hi[k][0],hi[k][1],hi[k][2],hi[k][3]}
    o[d0]=__builtin_amdgcn_mfma_f32_32x32x16_bf16(pa0,PK(0),o[d0],0,0,0);
    o[d0]=__builtin_amdgcn_mfma_f32_32x32x16_bf16(pa1,PK(1),o[d0],0,0,0);
    o[d0]=__builtin_amdgcn_mfma_f32_32x32x16_bf16(pa2,PK(2),o[d0],0,0,0);
    o[d0]=__builtin_amdgcn_mfma_f32_32x32x16_bf16(pa3,PK(3),o[d0],0,0,0);
    #undef PK
  }
}

#ifndef ATTN_STORE16
#define ATTN_STORE16(p,v) (*(u32x4*)(p)=(v))
#endif
__device__ __forceinline__ void attn_prefetch(const bf16*Qh,const bf16*Kh,int qb,bf16x8(&qn)[4],char*shm){
  const int tid=threadIdx.x,lane=tid&63,r32=lane&31,hi=lane>>5; const int wid=__builtin_amdgcn_readfirstlane(tid>>6);
  const unsigned lds0=(unsigned)(uintptr_t)shm; const bf16*ksrc=Kh+(long)lane*PQ+wid*8; const unsigned kdst=lds0+LDS_K+wid*1024;
  glds16(ksrc,(unsigned)__builtin_amdgcn_readfirstlane(kdst)); glds16(ksrc+(long)KVBLK*PQ,(unsigned)__builtin_amdgcn_readfirstlane(kdst+SLOTB)); glds16(ksrc+(long)2*KVBLK*PQ,(unsigned)__builtin_amdgcn_readfirstlane(kdst+2*SLOTB));
  const bf16*Qw=Qh+(long)(qb*QB+wid*QBLK)*PQ;
  #pragma unroll
  for(int d0=0;d0<4;++d0)qn[d0]=*reinterpret_cast<const bf16x8*>(&Qw[(long)r32*PQ+d0*16+hi*8]);
}
struct EpiArgs { int mode; bf16* out; const bf16* z; const bf16* od; const float* gsub; const float* lq1; const float* lk1; const float* lq2; const float* lk2; };
template<int THRL,bool WIDE> __device__ __forceinline__ void attn_unit(int qb,bf16x8(&qr)[4],const bf16*__restrict__ Kh,const bf16*__restrict__ Vh,const EpiArgs EA,const float*kmean,const bool has_next,const bf16*Qn,const bf16*Kn,int qbn,char*shm){
  const int tid=threadIdx.x,lane=tid&63,r32=lane&31,hi=lane>>5; const int wid=__builtin_amdgcn_readfirstlane(tid>>6);
  constexpr bool MOBA=!WIDE;
  const int q0=qb*QB;
  const unsigned lds0=(unsigned)(uintptr_t)shm;
  float*wsf=(float*)(shm+LDS_WS)+wid*64;
  const unsigned koff=(unsigned)((lane*PQ+wid*8)*2);
  const unsigned voff=(unsigned)(((16*(wid&3)+(lane>>2))*PQ+(wid>>2)*32+(lane&3)*8)*2);
  const unsigned kdst=lds0+LDS_K+wid*1024, vdst=lds0+LDS_V+wid*1024;
  #define DMA_K(t,slot) glds16s(Kh+(long)(t)*KVBLK*PQ,koff,(unsigned)__builtin_amdgcn_readfirstlane(kdst+(slot)))
  #define DMA_V(t,slot) do{ glds16s(Vh+(long)(t)*KVBLK*PQ,voff,(unsigned)__builtin_amdgcn_readfirstlane(vdst+2*(slot))); \
    if constexpr(WIDE) glds16s(Vh+(long)MROWS*64+(long)(t)*KVBLK*PQ,voff,(unsigned)__builtin_amdgcn_readfirstlane(vdst+2*(slot)+8192)); }while(0)
  #define WB(a,b) do{ if constexpr(WIDE){WAIT_BAR(b);} else {WAIT_BAR(a);} }while(0)
  const int vb0=(int)(lds0+LDS_V)+((lane>>4)&1)*32+(lane&3)*8+(4*hi+((lane&15)>>2))*64;
  const char*Kbase=shm+LDS_K; bf16x8 kf[8];
  const lds_cptr shm3=(lds_cptr)shm; const lds_cptr kp0=shm3+LDS_K+hi*1024+r32*16; const lds_cptr vp0=shm3+LDS_V+((lane>>4)&1)*32+(lane&3)*8+(4*hi+((lane&15)>>2))*64;
  const int NT=(q0+QB)/KVBLK;
  DMA_V(0,0);

  unsigned selmask=0xffu;
  if(MOBA && qb>=4){
    float g[7];
    #pragma unroll
    for(int blk=0;blk<7;++blk){ float s=-INFINITY;
      if(blk<qb){ const float*km=kmean+blk*512+hi*8; float a=0.f;
        #pragma unroll
        for(int d0=0;d0<4;++d0){ const f32x4_t ka=*reinterpret_cast<const f32x4_t*>(km+d0*16), kb2=*reinterpret_cast<const f32x4_t*>(km+d0*16+4);
          #pragma unroll
          for(int e=0;e<4;++e){ a+=__uint_as_float(((unsigned)(unsigned short)qr[d0][e])<<16)*ka[e]; a+=__uint_as_float(((unsigned)(unsigned short)qr[d0][4+e])<<16)*kb2[e]; } }
        s=a+__shfl_xor(a,32); }
      g[blk]=s; }
    selmask=1u<<qb;
    #pragma unroll
    for(int blk=0;blk<7;++blk){ int rank=0;
      #pragma unroll
      for(int b2=0;b2<7;++b2){ if(b2!=blk) rank+=((g[b2]>g[blk])||(g[b2]==g[blk]&&b2<blk))?1:0; }
      if(blk<qb&&rank<3) selmask|=1u<<blk; }
  }
  #define BMASK(P0,P1,t) do{ if(MOBA && (t)<NT-4){ if(!((selmask>>((t)>>2))&1u)){ _Pragma("unroll") for(int r_=0;r_<16;++r_){P0[r_]=-INFINITY;P1[r_]=-INFINITY;} } } }while(0)
  float mhat=0.f,l_reg=0.f;constexpr int NO=WIDE?4:2; f32x16 o[NO];
  #pragma unroll
  for(int d_=0;d_<NO;++d_)o[d_]=f32x16{};
  const f32x16 negm=f32x16{};
  const int qrel=wid*QBLK+r32;
  #define CMASK(P0,P1,t) do{int jb_=(t)-(NT-4); if(jb_>=0)cmask(P0,P1,jb_,qrel,hi); else BMASK(P0,P1,t);}while(0)
  bool resc=false;
  #define START(P0,P1) do{ const float rm=rowmax(P0,P1); resc=false; \
    { const float dl=MOBA?__builtin_fmaxf(rm,-1000.f):rm; mhat=fadd_s(mhat,dl); \
      _Pragma("unroll") for(int r=0;r<16;++r){P0[r]=fsub_s(P0[r],dl);P1[r]=fsub_s(P1[r],dl);} \
      } \
    _Pragma("unroll") for(int r=0;r<16;++r)P0[r]=__builtin_amdgcn_exp2f(P0[r]); }while(0)
  #define RESC() do{ if(resc){ asm volatile("s_waitcnt lgkmcnt(0)":::"memory"); \
      _Pragma("unroll") for(int d_=0;d_<NO;++d_) _Pragma("unroll") for(int r=0;r<16;++r)o[d_][r]*=wsb[(r&3)+8*(r>>2)]; } }while(0)
  typedef __attribute__((address_space(3))) const float* lds_fptr; const lds_fptr wsb=(lds_fptr)(shm3+LDS_WS)+wid*64+4*hi;
  f32x16 pA0,pA1,pB0,pB1; u32x4 pw0,pw1,pw2,pw3;
  u32x4 qw0,qw1,qw2,qw3; float sacc_c=0.f;
  int sl_prev=0,sl_cur=0,sl_next=SLOTB;
  #define ROT() do{sl_prev=sl_cur;sl_cur=sl_next;sl_next=(sl_next==(NSLOT-1)*SLOTB)?0:sl_next+SLOTB;}while(0)
  WB(1,2);
  qkt(pA0,pA1,Kbase,qr,negm,r32,hi);asm volatile("s_nop 15\n\ts_nop 7":"+v"(pA0),"+v"(pA1));CMASK(pA0,pA1,0);
  START(pA0,pA1);
  _Pragma("unroll") for(int r=0;r<16;++r)pA1[r]=__builtin_amdgcn_exp2f(pA1[r]);
  if constexpr(WIDE){ float s0_=pA0[0]+pA0[1]; _Pragma("unroll") for(int r=2;r<16;++r)s0_+=pA0[r]; _Pragma("unroll") for(int r=0;r<16;++r)s0_+=pA1[r]; sacc_c=s0_;
    pw0=(u32x4){cvtpk_s(pA0[0],pA0[1]),cvtpk_s(pA0[2],pA0[3]),cvtpk_s(pA0[4],pA0[5]),cvtpk_s(pA0[6],pA0[7])};pw1=(u32x4){cvtpk_s(pA0[8],pA0[9]),cvtpk_s(pA0[10],pA0[11]),cvtpk_s(pA0[12],pA0[13]),cvtpk_s(pA0[14],pA0[15])};
    pw2=(u32x4){cvtpk_s(pA1[0],pA1[1]),cvtpk_s(pA1[2],pA1[3]),cvtpk_s(pA1[4],pA1[5]),cvtpk_s(pA1[6],pA1[7])};pw3=(u32x4){cvtpk_s(pA1[8],pA1[9]),cvtpk_s(pA1[10],pA1[11]),cvtpk_s(pA1[12],pA1[13]),cvtpk_s(pA1[14],pA1[15])}; }
  WAIT_BAR(0);
  DMA_K(3,0);DMA_V(1,SLOTB);
  ROT();
  kload8(kf,kp0+sl_cur);
  WB(2,3);
  s16x4 vlo[8],vhi[8];
  #define PKW(P,B) cvtpk_s(P[B],P[B+1])
  #define PAF(k) __builtin_bit_cast(bf16x8,pw##k)
  #define PAFX(S,k) __builtin_bit_cast(bf16x8,S##k)
  #define SP(X,B,PW,c) do{ sacc_c+=X[B]; sacc_c+=X[B+1]; PW[c]=PKW(X,B); PIN(sacc_c); PIN(PW); }while(0)
  #define GW(MF,X,B,SPX) do{ MF; X[B]=EX(X[B]); X[B+1]=EX(X[B+1]); SPX; SBAR(); }while(0)
  #define VFR(i) (bf16x8){vlo[i][0],vlo[i][1],vlo[i][2],vlo[i][3],vhi[i][0],vhi[i][1],vhi[i][2],vhi[i][3]}
  #define PIN(x) asm volatile("":"+v"(x))
  #define MX3(a,b,c) __builtin_fmaxf(__builtin_fmaxf((a),(b)),(c))
  #define GAPA(MF,A0,A1,A2,A3,W0,W1,PW) do{ MF; sacc+=A0; sacc+=A1; sacc+=A2; sacc+=A3; PIN(sacc); W0; W1; PIN(PW); SBAR(); }while(0)
  #define EX(v) __builtin_amdgcn_exp2f(v)
  #define GAPB(MF,X,B) do{ MF; X[B]=EX(X[B]); X[B+1]=EX(X[B+1]); X[B+2]=EX(X[B+2]); X[B+3]=EX(X[B+3]); PIN(X); SBAR(); }while(0)
  #define VRD(i) do{ vlo[i]=vtr(vp_+(((i)>>2)*4096+((i)&3)*1024)); vhi[i]=vtr(vp_+(((i)>>2)*4096+((i)&3)*1024+512)); }while(0)
  #define KRD(G,j) do{ if(G){ kload2(kf,kp0+sl_next,j); SBAR(); } }while(0)
  #define VRD2(i) do{ if constexpr(WIDE){ vlo[i]=vtr(vp_+8192+(((i)>>2)*4096+((i)&3)*1024)); vhi[i]=vtr(vp_+8192+(((i)>>2)*4096+((i)&3)*1024+512)); SBAR(); } }while(0)
  #define STEP(C0,C1,P0,P1,t,GK,GV,GL,PWC,PWN) do{ SBAR(); \
    const lds_cptr vp_=vp0+2*sl_prev; \
    float sacc=0.f; if constexpr(!WIDE) sacc=(P0[0]+P0[1]); \
    if constexpr(WIDE){   \
      VRD(0); SBAR(); C0=__builtin_amdgcn_mfma_f32_32x32x16_bf16(kf[0],qr[0],negm,0,0,0); SBAR(); \
      VRD(4); SBAR(); C1=__builtin_amdgcn_mfma_f32_32x32x16_bf16(kf[1],qr[0],negm,0,0,0); SBAR(); \
      VRD(1); SBAR(); C0=__builtin_amdgcn_mfma_f32_32x32x16_bf16(kf[2],qr[1],C0,0,0,0); SBAR(); \
      VRD(5); SBAR(); C1=__builtin_amdgcn_mfma_f32_32x32x16_bf16(kf[3],qr[1],C1,0,0,0); SBAR(); \
      VRD(2); SBAR(); C0=__builtin_amdgcn_mfma_f32_32x32x16_bf16(kf[4],qr[2],C0,0,0,0); SBAR(); \
      VRD(6); SBAR(); C1=__builtin_amdgcn_mfma_f32_32x32x16_bf16(kf[5],qr[2],C1,0,0,0); SBAR(); \
      VRD(3); SBAR(); C0=__builtin_amdgcn_mfma_f32_32x32x16_bf16(kf[6],qr[3],C0,0,0,0); SBAR(); \
      VRD(7); SBAR(); C1=__builtin_amdgcn_mfma_f32_32x32x16_bf16(kf[7],qr[3],C1,0,0,0); SBAR(); \
    } else { \
    VRD(0); SBAR(); \
    GAPA(C0=__builtin_amdgcn_mfma_f32_32x32x16_bf16(kf[0],qr[0],negm,0,0,0), P0[2],P0[3],P0[4],P0[5],     pw0[0]=PKW(P0,0), pw0[1]=PKW(P0,2), pw0); \
    VRD(4); SBAR(); GAPA(C1=__builtin_amdgcn_mfma_f32_32x32x16_bf16(kf[1],qr[0],negm,0,0,0), P0[6],P0[7],P0[8],P0[9],     pw0[2]=PKW(P0,4), pw0[3]=PKW(P0,6), pw0); \
    VRD(1); SBAR(); GAPA(C0=__builtin_amdgcn_mfma_f32_32x32x16_bf16(kf[2],qr[1],C0,0,0,0),   P0[10],P0[11],P0[12],P0[13], pw1[0]=PKW(P0,8), pw1[1]=PKW(P0,10), pw1); \
    VRD(5); SBAR(); GAPA(C1=__builtin_amdgcn_mfma_f32_32x32x16_bf16(kf[3],qr[1],C1,0,0,0),   P0[14],P0[15],P1[0],P1[1],   pw1[2]=PKW(P0,12),pw1[3]=PKW(P0,14), pw1); \
    VRD(2); SBAR(); GAPA(C0=__builtin_amdgcn_mfma_f32_32x32x16_bf16(kf[4],qr[2],C0,0,0,0),   P1[2],P1[3],P1[4],P1[5],     pw2[0]=PKW(P1,0), pw2[1]=PKW(P1,2), pw2); \
    VRD(6); SBAR(); GAPA(C1=__builtin_amdgcn_mfma_f32_32x32x16_bf16(kf[5],qr[2],C1,0,0,0),   P1[6],P1[7],P1[8],P1[9],     pw2[2]=PKW(P1,4), pw2[3]=PKW(P1,6), pw2); \
    VRD(3); SBAR(); GAPA(C0=__builtin_amdgcn_mfma_f32_32x32x16_bf16(kf[6],qr[3],C0,0,0,0),   P1[10],P1[11],P1[12],P1[13], pw3[0]=PKW(P1,8), pw3[1]=PKW(P1,10), pw3); \
    VRD(7); SBAR(); GAPA(C1=__builtin_amdgcn_mfma_f32_32x32x16_bf16(kf[7],qr[3],C1,0,0,0),   P1[14],P1[15],0.f,0.f,       pw3[2]=PKW(P1,12),pw3[3]=PKW(P1,14), pw3); \
    } \
    if constexpr(WIDE){ l_reg+=sacc_c; sacc_c=0.f; } else { l_reg+=sacc; } \
    if(GK){DMA_K((t)+3,sl_cur);} if(GV){DMA_V((t)+1,sl_next);} \
    CMASK(C0,C1,t); \
    _Pragma("unroll") for(int r=0;r<16;++r){C0[r]-=mhat;C1[r]-=mhat;} \
    { float a=MX3(C0[0],C0[1],C1[0]),b=MX3(C0[2],C0[3],C1[1]); a=MX3(a,C1[2],C1[3]); \
      _Pragma("unroll") for(int r=4;r<16;r+=4){a=MX3(a,C0[r],C0[r+1]);b=MX3(b,C0[r+2],C0[r+3]);a=MX3(a,C1[r],C1[r+1]);b=MX3(b,C1[r+2],C1[r+3]);} \
      float rm=__builtin_fmaxf(a,b); { auto rr=__builtin_amdgcn_permlane32_swap(__float_as_uint(rm),__float_as_uint(rm),false,false); rm=__builtin_fmaxf(__uint_as_float(rr[0]),__uint_as_float(rr[1])); } \
      resc=false; \
      if(__builtin_expect(__any(rm>(float)THRL),0)){ const float dl=__builtin_fmaxf(rm,0.f); mhat+=dl; \
        _Pragma("unroll") for(int r=0;r<16;++r){C0[r]-=dl;C1[r]-=dl;} \
        const float f=__builtin_amdgcn_exp2f(-dl); l_reg*=f; if(hi==0)wsf[r32]=f; resc=true; } } \
    SBAR(); \
    if constexpr(WIDE){ \
      GW(o[0]=__builtin_amdgcn_mfma_f32_32x32x16_bf16(PAFX(PWC,0),VFR(0),o[0],0,0,0), C0,0,  (void)0); VRD2(0); \
      GW(o[1]=__builtin_amdgcn_mfma_f32_32x32x16_bf16(PAFX(PWC,0),VFR(4),o[1],0,0,0), C0,4,  SP(C0,0,PWN##0,0)); VRD2(4); \
      GW(o[0]=__builtin_amdgcn_mfma_f32_32x32x16_bf16(PAFX(PWC,1),VFR(1),o[0],0,0,0), C0,8,  SP(C0,4,PWN##0,2)); VRD2(1); \
      GW(o[1]=__builtin_amdgcn_mfma_f32_32x32x16_bf16(PAFX(PWC,1),VFR(5),o[1],0,0,0), C0,12, SP(C0,8,PWN##1,0)); VRD2(5); \
      GW(o[0]=__builtin_amdgcn_mfma_f32_32x32x16_bf16(PAFX(PWC,2),VFR(2),o[0],0,0,0), C1,0,  SP(C0,12,PWN##1,2)); VRD2(2); \
      GW(o[1]=__builtin_amdgcn_mfma_f32_32x32x16_bf16(PAFX(PWC,2),VFR(6),o[1],0,0,0), C1,4,  SP(C1,0,PWN##2,0)); VRD2(6); \
      GW(o[0]=__builtin_amdgcn_mfma_f32_32x32x16_bf16(PAFX(PWC,3),VFR(3),o[0],0,0,0), C1,8,  SP(C1,4,PWN##2,2)); VRD2(3); \
      GW(o[1]=__builtin_amdgcn_mfma_f32_32x32x16_bf16(PAFX(PWC,3),VFR(7),o[1],0,0,0), C1,12, SP(C1,8,PWN##3,0)); VRD2(7); \
        \
      GW(o[2]=__builtin_amdgcn_mfma_f32_32x32x16_bf16(PAFX(PWC,0),VFR(0),o[2],0,0,0), C0,2,  SP(C1,12,PWN##3,2)); \
      GW(o[3]=__builtin_amdgcn_mfma_f32_32x32x16_bf16(PAFX(PWC,0),VFR(4),o[3],0,0,0), C0,6,  SP(C0,2,PWN##0,1)); \
      KRD(GL,0); GW(o[2]=__builtin_amdgcn_mfma_f32_32x32x16_bf16(PAFX(PWC,1),VFR(1),o[2],0,0,0), C0,10, SP(C0,6,PWN##0,3)); \
      KRD(GL,1); GW(o[3]=__builtin_amdgcn_mfma_f32_32x32x16_bf16(PAFX(PWC,1),VFR(5),o[3],0,0,0), C0,14, SP(C0,10,PWN##1,1)); \
      KRD(GL,2); GW(o[2]=__builtin_amdgcn_mfma_f32_32x32x16_bf16(PAFX(PWC,2),VFR(2),o[2],0,0,0), C1,2,  SP(C0,14,PWN##1,3)); \
      KRD(GL,3); GW(o[3]=__builtin_amdgcn_mfma_f32_32x32x16_bf16(PAFX(PWC,2),VFR(6),o[3],0,0,0), C1,6,  SP(C1,2,PWN##2,1)); \
      GW(o[2]=__builtin_amdgcn_mfma_f32_32x32x16_bf16(PAFX(PWC,3),VFR(3),o[2],0,0,0), C1,10, SP(C1,6,PWN##2,3)); \
      GW(o[3]=__builtin_amdgcn_mfma_f32_32x32x16_bf16(PAFX(PWC,3),VFR(7),o[3],0,0,0), C1,14, SP(C1,10,PWN##3,1)); \
      SP(C1,14,PWN##3,3); SBAR(); \
    } else { \
    GAPB(o[0]=__builtin_amdgcn_mfma_f32_32x32x16_bf16(PAF(0),VFR(0),o[0],0,0,0), C0,0); VRD2(0); \
    GAPB(o[1]=__builtin_amdgcn_mfma_f32_32x32x16_bf16(PAF(0),VFR(4),o[1],0,0,0), C0,4); VRD2(4); \
    KRD(GL,0); GAPB(o[0]=__builtin_amdgcn_mfma_f32_32x32x16_bf16(PAF(1),VFR(1),o[0],0,0,0), C0,8); VRD2(1); \
    KRD(GL,1); GAPB(o[1]=__builtin_amdgcn_mfma_f32_32x32x16_bf16(PAF(1),VFR(5),o[1],0,0,0), C0,12); VRD2(5); \
    KRD(GL,2); GAPB(o[0]=__builtin_amdgcn_mfma_f32_32x32x16_bf16(PAF(2),VFR(2),o[0],0,0,0), C1,0); VRD2(2); \
    KRD(GL,3); GAPB(o[1]=__builtin_amdgcn_mfma_f32_32x32x16_bf16(PAF(2),VFR(6),o[1],0,0,0), C1,4); VRD2(6); \
    GAPB(o[0]=__builtin_amdgcn_mfma_f32_32x32x16_bf16(PAF(3),VFR(3),o[0],0,0,0), C1,8); VRD2(3); \
    GAPB(o[1]=__builtin_amdgcn_mfma_f32_32x32x16_bf16(PAF(3),VFR(7),o[1],0,0,0), C1,12); VRD2(7); \
    } \
    }while(0)
  int t=1;
  #undef CMASK
  #define CMASK(P0,P1,t) BMASK(P0,P1,t)
  for(;t+5<NT;t+=2){
    STEP(pB0,pB1,pA0,pA1,t,true,true,true,pw,qw);     WB(2,3); RESC(); ROT();
    STEP(pA0,pA1,pB0,pB1,t+1,true,true,true,qw,pw);   WB(2,3); RESC(); ROT();
  }
  #undef CMASK
  #define CMASK(P0,P1,t) do{int jb_=(t)-(NT-4); if(jb_>=0)cmask(P0,P1,jb_,qrel,hi); else BMASK(P0,P1,t);}while(0)
  #define ENDW(tt) do{ if((tt)+3<NT){WB(2,3);} else if((tt)+2<NT){WB(1,2);} else {WAIT_BAR(0);} }while(0)
  for(;t+1<NT;t+=2){
    STEP(pB0,pB1,pA0,pA1,t,(t+3<NT),(t+1<NT),(t+1<NT),pw,qw);       ENDW(t);   RESC(); ROT();
    STEP(pA0,pA1,pB0,pB1,t+1,(t+4<NT),(t+2<NT),(t+2<NT),qw,pw);     ENDW(t+1); RESC(); ROT();
  }
  STEP(pB0,pB1,pA0,pA1,NT-1,false,false,false,pw,qw); RESC();
  int le=lane; asm volatile("":"+v"(le)); const int r32e=le&31,hie=le>>5;
  if(has_next) attn_prefetch(Qn,Kn,qbn,qr,shm);
  const long orow0=(long)(q0+wid*QBLK)*1024;
  u32x4 pz[4][2],po[4][2];
  #pragma unroll
  for(int i=0;i<4;++i){ pz[i][0]=u32x4{};pz[i][1]=u32x4{};po[i][0]=u32x4{};po[i][1]=u32x4{}; }
  if(EA.mode!=1){
    #pragma unroll
    for(int i=0;i<4;++i){ const bf16*zp=EA.z+orow0+(long)(i*8+(le>>3))*1024+(le&7)*8; pz[i][0]=*(const u32x4*)(zp); if(EA.mode==2)pz[i][1]=*(const u32x4*)(zp+64); }
    if(EA.mode==2){
      #pragma unroll
      for(int i=0;i<4;++i){ const bf16*odp=EA.od+orow0+(long)(i*8+(le>>3))*1024+(le&7)*8; po[i][0]=*(const u32x4*)(odp); po[i][1]=*(const u32x4*)(odp+64); } }
  }
  if constexpr(WIDE){ l_reg+=sacc_c; SBAR(); pv(o,vb0+2*sl_cur,PAFX(qw,0),PAFX(qw,1),PAFX(qw,2),PAFX(qw,3)); pv(o+2,vb0+2*sl_cur+8192,PAFX(qw,0),PAFX(qw,1),PAFX(qw,2),PAFX(qw,3)); }
  else
  { float sacc=pB0[0]+pB0[1]; _Pragma("unroll") for(int r=2;r<16;++r)sacc+=pB0[r]; _Pragma("unroll") for(int r=0;r<16;++r)sacc+=pB1[r]; l_reg+=sacc;
    pw0=(u32x4){PKW(pB0,0),PKW(pB0,2),PKW(pB0,4),PKW(pB0,6)};pw1=(u32x4){PKW(pB0,8),PKW(pB0,10),PKW(pB0,12),PKW(pB0,14)};pw2=(u32x4){PKW(pB1,0),PKW(pB1,2),PKW(pB1,4),PKW(pB1,6)};pw3=(u32x4){PKW(pB1,8),PKW(pB1,10),PKW(pB1,12),PKW(pB1,14)};
    SBAR(); pv(o,vb0+2*sl_cur,PAF(0),PAF(1),PAF(2),PAF(3)); }
  #undef PKW
  #undef PAF
  #undef VFR
  #undef PIN
  #undef MX3
  #undef GAPA
  #undef GAPB
  #undef GW
  #undef SP
  #undef PAFX
  #undef EX
  #undef VRD
  #undef KRD
  #undef VRD2
  #undef STEP
  #undef ENDW
  {auto rr=__builtin_amdgcn_permlane32_swap(__float_as_uint(l_reg),__float_as_uint(l_reg),false,false);l_reg=__uint_as_float(rr[0])+__uint_as_float(rr[1]);}
  if(hie==0)wsf[32+r32e]=l_reg;asm volatile("s_waitcnt lgkmcnt(0)":::"memory");
  float rli[16];
  #pragma unroll
  for(int r=0;r<16;++r)rli[r]=__builtin_amdgcn_rcpf(wsf[32+crow(r,hie)]);
  { bf16*stg=(bf16*)(shm+LDS_OST)+wid*2048;
    #define BFLO(u) __uint_as_float((u)<<16)
    #define BFHI(u) __uint_as_float((u)&0xffff0000u)
    #pragma unroll
    for(int r=0;r<16;++r){const int orow=crow(r,hie);
      #pragma unroll
      for(int d0=0;d0<2;++d0)stg[orow*64+d0*32+r32e]=__float2bfloat16(o[d0][r]*rli[r]);}
    asm volatile("s_waitcnt lgkmcnt(0)":::"memory");
    if constexpr(!WIDE){
      #pragma unroll
      for(int i=0;i<4;++i){const int row=i*8+(le>>3),ch=le&7; const u32x4 v=*(const u32x4*)(stg+row*64+ch*8); const u32x4 zz=pz[i][0]; u32x4 y;
        #pragma unroll
        for(int e=0;e<4;++e) y[e]=cvtpk_s(BFLO(v[e])*BFLO(zz[e]),BFHI(v[e])*BFHI(zz[e]));
        ATTN_STORE16(EA.out+orow0+(long)row*1024+ch*8,y);}
    } else {
      u32x4 va[4];
      #pragma unroll
      for(int i=0;i<4;++i){const int row=i*8+(le>>3),ch=le&7; va[i]=*(const u32x4*)(stg+row*64+ch*8); if(EA.mode==1)ATTN_STORE16(EA.out+orow0+(long)row*1024+ch*8,va[i]);}
      asm volatile("s_waitcnt lgkmcnt(0)":::"memory");
      #pragma unroll
      for(int r=0;r<16;++r){const int orow=crow(r,hie);
        #pragma unroll
        for(int d0=0;d0<2;++d0)stg[orow*64+d0*32+r32e]=__float2bfloat16(o[2+d0][r]*rli[r]);}
      asm volatile("s_waitcnt lgkmcnt(0)":::"memory");
      if(EA.mode==1){
        #pragma unroll
        for(int i=0;i<4;++i){const int row=i*8+(le>>3),ch=le&7; const u32x4 v=*(const u32x4*)(stg+row*64+ch*8); ATTN_STORE16(EA.out+orow0+(long)row*1024+64+ch*8,v);}
      } else {
        float t1=EA.lq1[le]*EA.lk1[le],t2=EA.lq2[le]*EA.lk2[le];
        #pragma unroll
        for(int o_=1;o_<64;o_<<=1){t1+=__shfl_xor(t1,o_);t2+=__shfl_xor(t2,o_);}
        const float lam=__expf(t1)-__expf(t2)+0.2f;
        #pragma unroll
        for(int i=0;i<4;++i){const int row=i*8+(le>>3),ch=le&7; const u32x4 vb=*(const u32x4*)(stg+row*64+ch*8); const u32x4 v0=va[i];
          const u32x4 o00=po[i][0],o01=po[i][1]; const u32x4 za=pz[i][0],zb=pz[i][1];
          float a[8],b[8]; float ss=0.f;
          #pragma unroll
          for(int e=0;e<4;++e){ a[2*e]=BFLO(o00[e])-lam*BFLO(v0[e]); a[2*e+1]=BFHI(o00[e])-lam*BFHI(v0[e]); b[2*e]=BFLO(o01[e])-lam*BFLO(vb[e]); b[2*e+1]=BFHI(o01[e])-lam*BFHI(vb[e]); }
          #pragma unroll
          for(int e=0;e<8;++e) ss+=a[e]*a[e]+b[e]*b[e];
          ss+=__shfl_xor(ss,1); ss+=__shfl_xor(ss,2); ss+=__shfl_xor(ss,4);
          const float rs=__builtin_amdgcn_rsqf(ss*(1.f/128.f)+1e-6f)*0.8f;
          const f32x4_t ga0=*reinterpret_cast<const f32x4_t*>(EA.gsub+ch*8),ga1=*reinterpret_cast<const f32x4_t*>(EA.gsub+ch*8+4),gb0=*reinterpret_cast<const f32x4_t*>(EA.gsub+64+ch*8),gb1=*reinterpret_cast<const f32x4_t*>(EA.gsub+64+ch*8+4);
          u32x4 ya,yb;
          #pragma unroll
          for(int e=0;e<4;++e){ const float g0=(e<2)?ga0[2*e]:ga1[2*e-4], g1=(e<2)?ga0[2*e+1]:ga1[2*e-3], h0=(e<2)?gb0[2*e]:gb1[2*e-4], h1=(e<2)?gb0[2*e+1]:gb1[2*e-3];
            ya[e]=cvtpk_s(a[2*e]*rs*g0*BFLO(za[e]),a[2*e+1]*rs*g1*BFHI(za[e])); yb[e]=cvtpk_s(b[2*e]*rs*h0*BFLO(zb[e]),b[2*e+1]*rs*h1*BFHI(zb[e])); }
          ATTN_STORE16(EA.out+orow0+(long)row*1024+ch*8,ya); ATTN_STORE16(EA.out+orow0+(long)row*1024+64+ch*8,yb);}
      }
    }
    #undef BFLO
    #undef BFHI
  }
  asm volatile("s_waitcnt lgkmcnt(0)\n\ts_barrier":::"memory");
  #undef DMA_K
  #undef DMA_V
  #undef WB
  #undef CMASK
  #undef BMASK
  #undef START
  #undef RESC
  #undef ROT
}
constexpr int ATTN_LDS_BYTES=LDS_BYTES;
struct AttnArgs { const bf16* proj; const bf16* z; bf16* y; bf16* od; const float* kmean; const float* gsub; const float* lq1; const float* lk1; const float* lq2; const float* lk2; };
__device__ __forceinline__ void attn_geom(int i,int j,const bf16*base,const bf16*&q,const bf16*&k,const bf16*&vv,int&qb){
  const bool mb=i<8; const int d=i-8,h=d>>1,mp=d&1; qb=((mb?i:h)&1)?7-j:j;
  const int gq=mb?i:24+h*2+mp, gk=mb?8+i:32+h*2+mp, gv=mb?16+i:40+h*2;
  q=base+(long)gq*MROWS*64; k=base+(long)gk*MROWS*64; vv=base+(long)gv*MROWS*64;
}
template<int THRL=8> __device__ __forceinline__ void attn_phase(char*lds,const AttnArgs&T,int vcu,int G){
  for(int v=vcu;v<256;v+=G){
    const int g=v>>3,j=v&7; const bf16*base=T.proj+(long)g*SEQ*PQ;
    const long rb=(long)g*SEQ*1024;
    bf16x8 qr[4]; const bf16*q,*k,*vv; int qb; attn_geom(0,j,base,q,k,vv,qb);
    attn_prefetch(q,k,qb,qr,lds);
    for(int i=0;i<16;++i){ const bool mb=i<8; const int d=i-8,h=d>>1,mp=d&1;
      attn_geom(i,j,base,q,k,vv,qb);
      const bf16*qn,*kn,*vn; int qbn; attn_geom(i<15?i+1:15,j,base,qn,kn,vn,qbn);
      EpiArgs EA; EA.mode=mb?0:(mp?2:1);
      EA.out=mb?T.y+rb+i*64:(mp?T.y+rb+512+h*128:T.od+rb+h*256);
      EA.z=mb?T.z+rb+i*64:T.z+rb+512+h*128; EA.od=T.od+rb+h*256; EA.gsub=T.gsub; EA.lq1=T.lq1; EA.lk1=T.lk1; EA.lq2=T.lq2; EA.lk2=T.lk2;
      if(mb) attn_unit<THRL,false>(qb,qr,k,vv,EA,T.kmean+g*4096+(i&7)*64,true,qn,kn,qbn,lds);
      else   attn_unit<THRL,true>(qb,qr,k,vv,EA,T.kmean,i<15,qn,kn,qbn,lds); }
  }
}
#undef SBAR
#undef WAIT_BAR
}
constexpr int NWAVES = 8;
#ifndef MK_N_LAUNCHES
#define MK_N_LAUNCHES 1
#endif
constexpr int N_PHASES = 8;
constexpr int N_LAUNCHES = MK_N_LAUNCHES;
constexpr int BATCH = 32, SEQ = 2048, D = 1024, PLE = 256, PROJ = 4096;
constexpr int M = BATCH * SEQ;
constexpr float EPS = 1e-6f;
constexpr size_t MiB = 1u << 20;
constexpr size_t WS_WIN = 2 * MiB, WS_WOUT = 10 * MiB, WS_WG = 12 * MiB, WS_WPLE = 14 * MiB;
constexpr size_t WS_ROPE = 15 * MiB;
constexpr size_t WS_KMEAN = 16 * MiB;
constexpr size_t WS_CNT = 1 * MiB;
constexpr size_t WS_PART = 20 * MiB;
constexpr size_t WS_PART2 = 24 * MiB;
constexpr size_t WS_PROJ = 32 * MiB;
constexpr size_t WS_Z = 416 * MiB;
constexpr size_t WS_HB = 32 * MiB, WS_PE = 160 * MiB;
constexpr size_t WS_XN = 544 * MiB;
constexpr size_t WS_OM = 672 * MiB;
constexpr size_t WS_OD = 736 * MiB;
constexpr size_t WS_PB = 864 * MiB;
constexpr size_t WS_END = 896 * MiB;
constexpr int RING_OFF = 0, RING_BYTES = 131072;
constexpr int LDS_BYTES = 147456;

#define GAS __attribute__((address_space(1)))
#define LAS __attribute__((address_space(3)))
typedef unsigned short bf16;
typedef unsigned v4u __attribute__((ext_vector_type(4)));
typedef float f32x4 __attribute__((ext_vector_type(4)));
#define LDS_WAIT() asm volatile("s_waitcnt lgkmcnt(0)" ::: "memory")
__device__ __forceinline__ unsigned f2bf(float f) { unsigned u = __builtin_bit_cast(unsigned, f); return (u + 0x7fffu + ((u >> 16) & 1u)) >> 16; }
__device__ __forceinline__ unsigned pk2(float lo, float hi) { return f2bf(lo) | (f2bf(hi) << 16); }
__device__ __forceinline__ float bflo(unsigned u) { return __uint_as_float(u << 16); }
__device__ __forceinline__ float bfhi(unsigned u) { return __uint_as_float(u & 0xffff0000u); }

typedef GAS unsigned gu32;
#define RLX_AGENT __ATOMIC_RELAXED, __HIP_MEMORY_SCOPE_AGENT
#define XB_TMO      128
#define XB_XCNT(j)  (256  + 64 * (j))
#define XB_XSUB(j)  (1280 + 64 * (j))
#define XB_XGEN(j)  (2304 + 64 * (j))
#define XB_TOP      3328
#define XB_TOPGEN   3392
#define XCD_BAR_WORDS 3456
#define XB_SPIN_CAP (1u << 18)

__device__ __forceinline__ unsigned xb_ld(unsigned* p)              { return __hip_atomic_load(p, __ATOMIC_RELAXED, __HIP_MEMORY_SCOPE_AGENT); }
__device__ __forceinline__ unsigned xb_add(unsigned* p, unsigned v) { return __hip_atomic_fetch_add(p, v, __ATOMIC_RELAXED, __HIP_MEMORY_SCOPE_AGENT); }
__device__ __forceinline__ unsigned xb_xcc_id() { return (unsigned)__builtin_amdgcn_s_getreg((3 << 11) | 20) & 0xFu; }
#define XB_SPIN(cond, bar) do { unsigned _sp = 0; while (cond) { __builtin_amdgcn_s_sleep(1); \
    if ((++_sp & 255u) == 0u) { if (xb_ld(&(bar)[XB_TMO])) break; if (_sp > XB_SPIN_CAP) { atomicAdd(&(bar)[XB_TMO], 1u); break; } } } } while (0)

struct XcdBarrier {
    unsigned* bar; unsigned x;
    volatile LAS unsigned* st;
};

__device__ __forceinline__ XcdBarrier xcd_barrier_post(unsigned* bar, volatile LAS unsigned* st) {
    XcdBarrier b; b.bar = bar; b.x = xb_xcc_id(); b.st = st;
    if (threadIdx.x == 0) (void)xb_add(&bar[XB_XCNT(b.x)], 1u);
    return b;
}
__device__ __forceinline__ void xcd_barrier_complete(unsigned* bar, unsigned x, unsigned& nloc, unsigned& nx) {
    const unsigned G = gridDim.x * gridDim.y * gridDim.z;
    unsigned sum, cnt, mine, sp = 0u;
    for (;;) {
        sum = 0u; cnt = 0u; mine = 0u;
#pragma unroll
        for (unsigned j = 0; j < 16; ++j) { const unsigned c = xb_ld(&bar[XB_XCNT(j)]); sum += c; cnt += (c > 0u) ? 1u : 0u; mine = (j == x) ? c : mine; }
        if (sum == G) break;
        __builtin_amdgcn_s_sleep(1);
        if ((++sp & 255u) == 0u) { if (xb_ld(&bar[XB_TMO])) break; if (sp > XB_SPIN_CAP) { atomicAdd(&bar[XB_TMO], 1u); break; } }
    }
    nloc = mine > 0u ? mine : 1u; nx = cnt > 0u ? cnt : 1u;
}

__device__ __forceinline__ void xcd_barrier(const XcdBarrier& b) {
    asm volatile("s_waitcnt vmcnt(0)" ::: "memory");
    __syncthreads();
    if (threadIdx.x == 0) {
        unsigned* bar = b.bar;
        __builtin_amdgcn_s_waitcnt(0);
        unsigned nloc = b.st[0], nx = b.st[1];
        if (nloc == 0u) { xcd_barrier_complete(bar, b.x, nloc, nx); b.st[0] = nloc; b.st[1] = nx; }
        const unsigned old = xb_add(&bar[XB_XSUB(b.x)], 1u);
        const unsigned gen = old / nloc;
        if (old + 1u == (gen + 1u) * nloc) {
            __builtin_amdgcn_fence(__ATOMIC_RELEASE, "agent");
            asm volatile("s_waitcnt vmcnt(0)" ::: "memory");
            const unsigned og = xb_add(&bar[XB_TOP], 1u);
            const unsigned tg = og / nx;
            if (og + 1u == (tg + 1u) * nx) xb_add(&bar[XB_TOPGEN], 1u);
            else XB_SPIN(xb_ld(&bar[XB_TOPGEN]) == tg, bar);
            __builtin_amdgcn_fence(__ATOMIC_ACQUIRE, "agent");
            xb_add(&bar[XB_XGEN(b.x)], 1u);
            asm volatile("s_waitcnt vmcnt(0)" ::: "memory");
        } else {
            XB_SPIN(xb_ld(&bar[XB_XGEN(b.x)]) == gen, bar);
            __builtin_amdgcn_fence(__ATOMIC_ACQUIRE, "agent");
            asm volatile("s_waitcnt vmcnt(0)" ::: "memory");
        }
    }
    __syncthreads();
}

struct Frame {
    LAS unsigned char* lds;
    int tid, lane, wave, vcu, G;
    const float *x, *p, *w_in, *w_out, *g_mix, *lq1, *lk1, *lq2, *lk2, *g_subln, *w_ple, *w_gate, *g_ple, *g_final; float* out;
    bf16 *WinT, *WoutT, *WgT, *WpleT, *PROJB, *ZB, *HB, *PE, *XN, *OM, *OD, *PB;
    float *ROPE, *KMEAN, *PART, *PART2; unsigned* CNT;
};
__device__ __forceinline__ float wave_sum(float v) {
#pragma unroll
    for (int o = 1; o < 64; o <<= 1) v += __shfl_xor(v, o);
    return v;
}
__device__ __forceinline__ void p0_transpose_item(const float* W, int K, int N, bf16* WT, const float* kscale, LAS float* scr, int item, int lane, bool perm64 = false) {
    const int nblk = N / 32, kb = item / nblk, nb = item % nblk, k0 = 64 * kb, n0 = 32 * nb;
    const int n0w = perm64 ? (nb >> 3) * 256 + (nb & 1) * 128 + ((nb & 7) >> 1) * 32 : n0;
#pragma unroll 8
    for (int i = 0; i < 32; ++i) { const int kk = 2 * i + (lane >> 5); float w = W[(size_t)(k0 + kk) * N + n0 + (lane & 31)]; if (kscale) w *= kscale[k0 + kk]; scr[kk * 33 + (lane & 31)] = w; }
    LDS_WAIT(); asm volatile("" ::: "memory");
    const int c = lane & 7;
#pragma unroll
    for (int j = 0; j < 4; ++j) { const int n = (lane >> 3) + 8 * j; const LAS float* s = scr + (8 * c) * 33 + n;
        v4u o; o.x = pk2(s[0 * 33], s[1 * 33]); o.y = pk2(s[2 * 33], s[3 * 33]); o.z = pk2(s[4 * 33], s[5 * 33]); o.w = pk2(s[6 * 33], s[7 * 33]);
        *(GAS v4u*)(WT + (size_t)(n0w + n) * K + k0 + 8 * c) = o; }
    LDS_WAIT(); asm volatile("" ::: "memory");
}
__device__ __forceinline__ void p0_prologue(Frame& F) {
    LAS float* scr = (LAS float*)(F.lds + RING_OFF + F.wave * 16384);
    const int gw = F.vcu * NWAVES + F.wave, NGW = F.G * NWAVES;
    constexpr int I_IN = (D / 64) * (PROJ / 32), I_OUT = (D / 64) * (D / 32), I_G = I_OUT, I_PLE = (PLE / 64) * (D / 32);
    constexpr int NITEMS = I_IN + I_OUT + I_G + I_PLE;
    for (int it = gw; it < NITEMS; it += NGW) {
        int r = it;
        if (r < I_IN) { p0_transpose_item(F.w_in, D, PROJ, F.WinT, nullptr, scr, r, F.lane, true); continue; } r -= I_IN;
        if (r < I_OUT) { p0_transpose_item(F.w_out, D, D, F.WoutT, nullptr, scr, r, F.lane); continue; } r -= I_OUT;
        if (r < I_G) { p0_transpose_item(F.w_gate, D, D, F.WgT, F.g_ple, scr, r, F.lane); continue; } r -= I_G;
        p0_transpose_item(F.w_ple, PLE, D, F.WpleT, nullptr, scr, r, F.lane);
    }
    if (F.vcu == 0 && F.tid < 256) F.CNT[64 * F.tid] = 0u;
    { const int gt = F.vcu * (NWAVES * 64) + F.tid;
      if (gt < SEQ * 8) { const int pos = gt >> 3, j = gt & 7;
        const double inv = (j == 0) ? 0.15915494309189535 : (j == 1) ? 0.03086376340470123 : (j == 2) ? 0.005985185712713705 : (j == 3) ? 0.001160663641240061 : (j == 4) ? 0.00022507907903927653 : (j == 5) ? 4.364795279280289e-05 : (j == 6) ? 8.464330808241401e-06 : 1.6414262627950345e-06;
        double rev = (double)pos * inv; rev -= __builtin_rint(rev); const float rf = (float)rev;
        F.ROPE[pos * 16 + j] = __builtin_amdgcn_cosf(rf); F.ROPE[pos * 16 + 8 + j] = __builtin_amdgcn_sinf(rf); } }
    { f32x4 g[4];
#pragma unroll
      for (int j = 0; j < 4; ++j) g[j] = ((const GAS f32x4*)F.g_mix)[F.lane + 64 * j];
      for (int m0 = gw * 4; m0 < M; m0 += NGW * 4) {
        f32x4 v[4][4]; float s2[4];
#pragma unroll
        for (int r = 0; r < 4; ++r) { const GAS f32x4* xr = (const GAS f32x4*)(F.x + (size_t)(m0 + r) * D) + F.lane;
#pragma unroll
          for (int j = 0; j < 4; ++j) v[r][j] = __builtin_nontemporal_load(xr + 64 * j); }
#pragma unroll
        for (int r = 0; r < 4; ++r) { s2[r] = 0.f;
#pragma unroll
          for (int j = 0; j < 4; ++j) s2[r] += (v[r][j].x * v[r][j].x + v[r][j].y * v[r][j].y) + (v[r][j].z * v[r][j].z + v[r][j].w * v[r][j].w); }
#pragma unroll
        for (int o = 1; o < 64; o <<= 1) {
#pragma unroll
          for (int r = 0; r < 4; ++r) s2[r] += __shfl_xor(s2[r], o); }
#pragma unroll
        for (int r = 0; r < 4; ++r) { const float rs = 1.f / sqrtf(s2[r] * (1.f / D) + EPS);
          GAS unsigned long long* o8 = (GAS unsigned long long*)(F.XN + (size_t)(m0 + r) * D) + F.lane;
#pragma unroll
          for (int j = 0; j < 4; ++j) { const f32x4 w = v[r][j] * rs * g[j]; o8[64 * j] = (unsigned long long)pk2(w.x, w.y) | ((unsigned long long)pk2(w.z, w.w) << 32); } } } }
    { const size_t nthr = (size_t)F.G * NWAVES * 64; const size_t n8 = (size_t)M * PLE / 8;
      for (size_t i = (size_t)F.vcu * (NWAVES * 64) + F.tid; i < n8; i += nthr) { const f32x4 a = ((const GAS f32x4*)F.p)[2 * i], b = ((const GAS f32x4*)F.p)[2 * i + 1];
        v4u o; o.x = pk2(a.x, a.y); o.y = pk2(a.z, a.w); o.z = pk2(b.x, b.y); o.w = pk2(b.z, b.w); ((GAS v4u*)F.PB)[i] = o; } }
}
__device__ __forceinline__ void kmean_phase(Frame& F) {
    for (int u = F.vcu; u < BATCH * 8; u += F.G) {
        const bf16* kb = F.PROJB + ((size_t)(8 + F.wave) * M + (size_t)u * 256 + (F.lane >> 3)) * 64 + 8 * (F.lane & 7);
        float a[8];
#pragma unroll
        for (int e = 0; e < 8; ++e) a[e] = 0.f;
#pragma unroll 8
        for (int r = 0; r < 32; ++r) { const v4u v = *(const GAS v4u*)(kb + (size_t)r * 8 * 64);
            a[0] += bflo(v.x); a[1] += bfhi(v.x); a[2] += bflo(v.y); a[3] += bfhi(v.y); a[4] += bflo(v.z); a[5] += bfhi(v.z); a[6] += bflo(v.w); a[7] += bfhi(v.w); }
#pragma unroll
        for (int e = 0; e < 8; ++e) { a[e] += __shfl_xor(a[e], 8); a[e] += __shfl_xor(a[e], 16); a[e] += __shfl_xor(a[e], 32); }
        if (F.lane < 8) {
#pragma unroll
            for (int e = 0; e < 8; ++e) F.KMEAN[(size_t)u * 512 + F.wave * 64 + F.lane * 8 + e] = a[e] * (1.f / 256.f); }
    }
}
__device__ __forceinline__ void final_phase(Frame& F) {
    const int gw = F.vcu * NWAVES + F.wave, NGW = F.G * NWAVES;
    f32x4 g[4];
#pragma unroll
    for (int j = 0; j < 4; ++j) g[j] = ((const GAS f32x4*)F.g_final)[F.lane + 64 * j];
    for (int m0 = gw * 4; m0 < M; m0 += NGW * 4) {
        f32x4 v[4][4]; float s2[4];
#pragma unroll
        for (int r = 0; r < 4; ++r) { const GAS f32x4* xr = (const GAS f32x4*)(F.out + (size_t)(m0 + r) * D) + F.lane;
#pragma unroll
          for (int j = 0; j < 4; ++j) v[r][j] = xr[64 * j]; }
#pragma unroll
        for (int r = 0; r < 4; ++r) { s2[r] = 0.f;
#pragma unroll
          for (int j = 0; j < 4; ++j) s2[r] += (v[r][j].x * v[r][j].x + v[r][j].y * v[r][j].y) + (v[r][j].z * v[r][j].z + v[r][j].w * v[r][j].w); }
#pragma unroll
        for (int o = 1; o < 64; o <<= 1) {
#pragma unroll
          for (int r = 0; r < 4; ++r) s2[r] += __shfl_xor(s2[r], o); }
#pragma unroll
        for (int r = 0; r < 4; ++r) { const float rs = 1.f / sqrtf(s2[r] * (1.f / D) + EPS);
          GAS f32x4* xw = (GAS f32x4*)(F.out + (size_t)(m0 + r) * D) + F.lane;
#pragma unroll
          for (int j = 0; j < 4; ++j) __builtin_nontemporal_store(v[r][j] * rs * g[j], xw + 64 * j); }
    }
}

struct Args { const float* in[14]; float* out; unsigned char* ws; int ph_lo, ph_hi, cgsync, pad; };
__global__ void __launch_bounds__(NWAVES * 64, 2) mk_fwd(Args args) {
    extern __shared__ __attribute__((aligned(16))) unsigned char lds[];
    Frame F;
    F.lds = (LAS unsigned char*)lds;
    F.tid = threadIdx.x; F.lane = F.tid & 63; F.wave = __builtin_amdgcn_readfirstlane(F.tid >> 6);
    F.G = gridDim.x; { const int bx = blockIdx.x; F.vcu = (F.G % 8 == 0) ? (bx % 8) * (F.G / 8) + bx / 8 : bx; }
    unsigned char* ws = args.ws;
    F.x = args.in[0]; F.p = args.in[1]; F.w_in = args.in[2]; F.w_out = args.in[3]; F.g_mix = args.in[4]; F.lq1 = args.in[5]; F.lk1 = args.in[6]; F.lq2 = args.in[7]; F.lk2 = args.in[8];
    F.g_subln = args.in[9]; F.w_ple = args.in[10]; F.w_gate = args.in[11]; F.g_ple = args.in[12]; F.g_final = args.in[13]; F.out = args.out;
    F.WinT = (bf16*)(ws + WS_WIN); F.WoutT = (bf16*)(ws + WS_WOUT); F.WgT = (bf16*)(ws + WS_WG); F.WpleT = (bf16*)(ws + WS_WPLE);
    F.PROJB = (bf16*)(ws + WS_PROJ); F.ZB = (bf16*)(ws + WS_Z); F.HB = (bf16*)(ws + WS_HB); F.PE = (bf16*)(ws + WS_PE); F.XN = (bf16*)(ws + WS_XN); F.OM = (bf16*)(ws + WS_OM); F.OD = (bf16*)(ws + WS_OD); F.PB = (bf16*)(ws + WS_PB);
    F.ROPE = (float*)(ws + WS_ROPE); F.KMEAN = (float*)(ws + WS_KMEAN); F.PART = (float*)(ws + WS_PART); F.PART2 = (float*)(ws + WS_PART2); F.CNT = (unsigned*)(ws + WS_CNT);
    const int lo = args.ph_lo, hi = args.ph_hi;
    volatile LAS unsigned* MISC = (volatile LAS unsigned*)(F.lds + RING_BYTES + 320);
    if (F.tid < 32) MISC[F.tid] = 0u;
    __syncthreads();
    XcdBarrier bar = xcd_barrier_post((unsigned*)ws, MISC + 8);
#ifndef REP_PHASE
#define REP_PHASE -1
#endif
#define NREP(k) (((k) == REP_PHASE) ? 2 : 1)
#ifndef PHMASK
#define PHMASK 0xff
#endif
#define IN(k) (((PHMASK >> (k)) & 1) && lo <= (k) && (k) < hi)
#define GRIDBAR() do { if (args.cgsync) cg::this_grid().sync(); else xcd_barrier(bar); } while (0)
#define SEAM3B do { if (IN(3) && IN(5)) { GRIDBAR(); } } while (0)
#define SEAM(k) do { if (IN(k) && IN((k) + 1)) { GRIDBAR(); } } while (0)

    if (IN(0)) { for (int rp = 0; rp < NREP(0); ++rp) p0_prologue(F); }
    SEAM(0);
    if (IN(1)) {
        pg8::Gemm g{F.XN, F.WinT, M, PROJ, D}; pg8::StaticOrder S; S.init(M, PROJ, F.G, (int)blockIdx.x);
        pg8::EpiProj E{F.PROJB, F.ZB, F.ROPE};
        pg8::gemm_phase<pg8::EpiProj, pg8::StaticOrder, PG8_ALIGN, PG8_SP2>(F.lds + RING_OFF, g, S, E);
    }
    if (IN(1) && NREP(1) == 2) {
        pg8::Gemm g{F.XN, F.WinT, M, PROJ, D}; pg8::StaticOrder S; S.init(M, PROJ, F.G, (int)blockIdx.x);
        pg8::EpiProj E{F.PROJB, F.ZB, F.ROPE};
        pg8::gemm_phase<pg8::EpiProj, pg8::StaticOrder, PG8_ALIGN, PG8_SP2>(F.lds + RING_OFF, g, S, E);
    }
    SEAM(1);
    if (IN(2)) { for (int rp = 0; rp < NREP(2); ++rp) kmean_phase(F); }
    SEAM(2);
    if (IN(3)) for (int rp = 0; rp < NREP(3); ++rp) {
        const attn_body::AttnArgs AT{(const attn_body::bf16*)F.PROJB, (const attn_body::bf16*)F.ZB, (attn_body::bf16*)F.XN, (attn_body::bf16*)F.OD, F.KMEAN, F.g_subln, F.lq1, F.lk1, F.lq2, F.lk2};
        attn_body::attn_phase<8>((char*)lds + RING_OFF, AT, F.vcu, F.G);
    }
    SEAM3B;
    if (IN(5)) {
        { pg8::Gemm g{F.XN, F.WoutT, M, D, D}; pg8::StaticOrder S; S.init(M, D, F.G, (int)blockIdx.x);
          pg8::EpiOut E{F.x, F.HB, F.PART};
          pg8::gemm_phase<pg8::EpiOut, pg8::StaticOrder, PG8_ALIGN, PG8_SP2>(F.lds + RING_OFF, g, S, E); }
        { int kple = PLE; asm volatile("" : "+s"(kple));
          pg8::Gemm g{F.PB, F.WpleT, M, D, kple}; pg8::StaticOrder S; S.init(M, D, F.G, (int)blockIdx.x);
          pg8::EpiBf16<0> E{F.PE, D, nullptr, 0, 0, 1.f};
          pg8::gemm_phase<pg8::EpiBf16<0>, pg8::StaticOrder, PG8_ALIGN, PG8_SP2>(F.lds + RING_OFF, g, S, E); }
    }
    if (IN(5) && NREP(5) == 2) {
        { pg8::Gemm g{F.XN, F.WoutT, M, D, D}; pg8::StaticOrder S; S.init(M, D, F.G, (int)blockIdx.x);
          pg8::EpiOut E{F.x, F.HB, F.PART};
          pg8::gemm_phase<pg8::EpiOut, pg8::StaticOrder, PG8_ALIGN, PG8_SP2>(F.lds + RING_OFF, g, S, E); }
        { int kple = PLE; asm volatile("" : "+s"(kple));
          pg8::Gemm g{F.PB, F.WpleT, M, D, kple}; pg8::StaticOrder S; S.init(M, D, F.G, (int)blockIdx.x);
          pg8::EpiBf16<0> E{F.PE, D, nullptr, 0, 0, 1.f};
          pg8::gemm_phase<pg8::EpiBf16<0>, pg8::StaticOrder, PG8_ALIGN, PG8_SP2>(F.lds + RING_OFF, g, S, E); }
    }
    SEAM(5);
    if (IN(6)) {
        pg8::Gemm g{F.HB, F.WgT, M, D, D}; pg8::StaticOrder S; S.init(M, D, F.G, (int)blockIdx.x);
        pg8::EpiGate E{F.HB, F.PE, F.out, F.PART, F.PART2, F.CNT, F.g_final};
        pg8::gemm_phase<pg8::EpiGate, pg8::StaticOrder, PG8_ALIGN, PG8_SP2>(F.lds + RING_OFF, g, S, E);
    }
#undef IN
#undef SEAM
}

extern "C" void kernel_launch(void* const* d_in, const int* in_sizes, int n_in, void* d_out, int out_size, void* d_ws, size_t ws_size, hipStream_t stream) {
    static int grid = 0;
    if (grid == 0) {
        if (n_in != 14 || in_sizes[0] != M * D || out_size != M * D || ws_size < WS_END) { fprintf(stderr, "kernel_launch: shape/workspace mismatch: n_in %d, in0 %d, out %d, ws %zu (need %zu)\n", n_in, n_in > 0 ? in_sizes[0] : -1, out_size, ws_size, (size_t)WS_END); grid = -1; return; }
        int dev = 0, cus = 0, per_cu = 0;
        if (hipGetDevice(&dev) != hipSuccess || hipDeviceGetAttribute(&cus, hipDeviceAttributeMultiprocessorCount, dev) != hipSuccess) { fprintf(stderr, "kernel_launch: device query failed\n"); grid = -1; return; }
        if (hipFuncSetAttribute((const void*)mk_fwd, hipFuncAttributeMaxDynamicSharedMemorySize, LDS_BYTES) != hipSuccess) { fprintf(stderr, "kernel_launch: hipFuncSetAttribute failed\n"); grid = -1; return; }
        if (hipOccupancyMaxActiveBlocksPerMultiprocessor(&per_cu, (const void*)mk_fwd, NWAVES * 64, LDS_BYTES) != hipSuccess || per_cu < 1) { fprintf(stderr, "kernel_launch: occupancy query reports %d\n", per_cu); per_cu = 1; }
        (void)hipGetLastError();
        grid = cus;
    }
    if (grid < 0) return;
    if (hipMemsetAsync(d_ws, 0, 65536, stream) != hipSuccess) { fprintf(stderr, "kernel_launch: hipMemsetAsync failed\n"); return; }
    Args a{};
    for (int i = 0; i < 14; ++i) a.in[i] = (const float*)d_in[i];
    a.out = (float*)d_out; a.ws = (unsigned char*)d_ws;
    if (N_LAUNCHES == 1) {
        a.ph_lo = 0; a.ph_hi = N_PHASES;
        void* kargs[] = {&a};
        const hipError_t le = hipLaunchCooperativeKernel((const void*)mk_fwd, dim3(grid), dim3(NWAVES * 64), kargs, LDS_BYTES, stream);
        if (le != hipSuccess) fprintf(stderr, "kernel_launch: cooperative launch failed: %s (grid %d)\n", hipGetErrorString(le), grid);
    } else {
        for (int li = 0; li < N_PHASES; ++li) {
            a.ph_lo = li; a.ph_hi = li + 1;
            hipLaunchKernelGGL(mk_fwd, dim3(grid), dim3(NWAVES * 64), LDS_BYTES, stream, a);
            const hipError_t le = hipPeekAtLastError();
            if (le != hipSuccess) { fprintf(stderr, "kernel_launch: launch %d failed: %s\n", li, hipGetErrorName(le)); break; }
        }
    }
}
```

```cpp
#include <hip/hip_runtime.h>
#include <hip/hip_cooperative_groups.h>
#include <cstdio>
#include <cstdint>
namespace cg = cooperative_groups;
__device__ __forceinline__ int tid_now(int wave_s) { unsigned z = 0u; asm volatile("" : "+s"(z)); return wave_s * 64 + (int)__builtin_amdgcn_mbcnt_hi(~0u, __builtin_amdgcn_mbcnt_lo(~0u, z)); }
namespace pg8 {
#define PG8_LAS __attribute__((address_space(3)))
typedef unsigned short bf16_t;
typedef short bf16x8 __attribute__((ext_vector_type(8)));
typedef float f32x4 __attribute__((ext_vector_type(4)));
typedef unsigned u32x4 __attribute__((ext_vector_type(4)));
constexpr int BM = 256, BK = 64, HALF = 128, HTB = HALF * BK * 2  , STAGE_BYTES = 8 * HTB, NXCD = 8, WGM = 8;

__host__ __device__ __forceinline__ int lds_byte(int r, int c) { const int st = (r >> 4) * 2 + (c >> 5), rr = r & 15, cc = c & 31, ob = rr * 64 + cc * 2; return st * 1024 + (ob ^ (((ob >> 9) & 1) << 5)); }
__host__ __device__ __forceinline__ void stage_rc(int b, int& R, int& C) { const int st = b / 1024, sb = b % 1024, swz = sb ^ (((sb >> 9) & 1) << 5); R = (st >> 1) * 16 + swz / 64; C = (st & 1) * 32 + (swz % 64) / 2; }
__host__ __device__ __forceinline__ int perm32(int rho) { const int n = rho >> 4, i = rho & 15; return 8 * (i >> 2) + 4 * n + (i & 3); }

struct Unit { int pm, pn; };
struct Gemm { const bf16_t* A; const bf16_t* Bt; int M, N, K; };

struct StaticOrder {
    int nM, nN, nwg, G, c;
    __host__ __device__ void init(int M, int N, int G_, int c_) { nM = M / BM; nN = N / BM; nwg = nM * nN; G = G_; c = c_; }
    __host__ __device__ bool next(int i, Unit& u) const {
        const long L = (long)i * G + c; if (L >= nwg) return false;
        int wgid = (int)L; { const int q = nwg / NXCD, r = nwg % NXCD, xcd = wgid % NXCD, off = wgid / NXCD; wgid = (xcd < r ? xcd * (q + 1) : r * (q + 1) + (xcd - r) * q) + off; }
        const int nig = WGM * nN, gid = wgid / nig, fm = gid * WGM, gsz = (nM - fm) < WGM ? (nM - fm) : WGM;
        u.pm = fm + ((wgid % nig) % gsz); u.pn = (wgid % nig) / gsz; return true;
    }
    __device__ __forceinline__ void a_ready(const Unit&) const {}
    __device__ __forceinline__ void done(const Unit&) const {}
};

__device__ __forceinline__ unsigned cvt_pk_bf16(float lo, float hi) { unsigned r; asm volatile("v_cvt_pk_bf16_f32 %0, %1, %2" : "=v"(r) : "v"(lo), "v"(hi)); return r; }
typedef float f32x2 __attribute__((ext_vector_type(2)));
__device__ __forceinline__ f32x2 gelu_pk(f32x2 v) {
    const f32x2 av = __builtin_elementwise_abs(v), d = av * 0.2316418882f + 1.0f;
    f32x2 t; t.x = __builtin_amdgcn_rcpf(d.x); t.y = __builtin_amdgcn_rcpf(d.y);
    f32x2 q = t * 0.5307027145f + (-0.7265760135f); q = q * t + 0.7107068705f; q = q * t + (-0.142248368f); q = q * t + 0.127414796f; q = q * t;
    const f32x2 s = (v * v) * (-0.72134752044f);
    f32x2 e; e.x = __builtin_amdgcn_exp2f(s.x); e.y = __builtin_amdgcn_exp2f(s.y);
    const f32x2 m = v * (q * e), r = v - m;
    f32x2 o; o.x = v.x < 0.f ? m.x : r.x; o.y = v.y < 0.f ? m.y : r.y; return o;
}

template <int ACT  > struct EpiBf16 {
    static constexpr bool PERM = true, AFTER_DRAIN = false; static_assert(ACT == 0 || ACT == 1, "EpiBf16: ACT is 0 (none) or 1 (gelu_pk)");
    bf16_t* O; int ldc; const float* bias; int split_cols; size_t split_stride; float scale0;
    __device__ __forceinline__ void operator()(const f32x4 (&acc)[2][2][4][2], const Unit& u, int wr, int wc, int fr, int fq) const {
        const int row0 = u.pm * BM + wr * 64 + fr; int colt = u.pn * BM; bf16_t* base = O;
        float sc = 1.f; if (split_cols) { const int t = colt / split_cols; base += (size_t)t * split_stride; colt -= t * split_cols; if (t == 0) sc = scale0; }
        const int col0 = colt + wc * 32 + 8 * fq, bcol0 = u.pn * BM + wc * 32 + 8 * fq;
        f32x4 bv[2][2];
#pragma unroll
        for (int bj = 0; bj < 2; ++bj)
#pragma unroll
            for (int n = 0; n < 2; ++n) bv[bj][n] = bias ? *(const f32x4*)(bias + bcol0 + bj * HALF + 4 * n) : (f32x4){0.f, 0.f, 0.f, 0.f};
#pragma unroll
        for (int ai = 0; ai < 2; ++ai)
#pragma unroll
            for (int m = 0; m < 4; ++m) { bf16_t* rowp = base + (size_t)(row0 + ai * HALF + m * 16) * ldc + col0;
#pragma unroll
                for (int bj = 0; bj < 2; ++bj) { f32x4 v0 = acc[ai][bj][m][0] + bv[bj][0], v1 = acc[ai][bj][m][1] + bv[bj][1];
                    if (ACT == 1) { f32x2 a = gelu_pk((f32x2){v0[0], v0[1]}), b = gelu_pk((f32x2){v0[2], v0[3]}), c = gelu_pk((f32x2){v1[0], v1[1]}), d = gelu_pk((f32x2){v1[2], v1[3]});
                        v0 = (f32x4){a.x, a.y, b.x, b.y}; v1 = (f32x4){c.x, c.y, d.x, d.y}; }
                    v0 = v0 * sc; v1 = v1 * sc; u32x4 w; w.x = cvt_pk_bf16(v0[0], v0[1]); w.y = cvt_pk_bf16(v0[2], v0[3]); w.z = cvt_pk_bf16(v1[0], v1[1]); w.w = cvt_pk_bf16(v1[2], v1[3]);
                    *(u32x4*)(rowp + bj * HALF) = w; } }
    }
};
constexpr float QC2 = 0.125f * 1.4426950408889634f;
struct EpiProj {
    static constexpr bool PERM = true, AFTER_DRAIN = false;
    bf16_t* O; bf16_t* Z; const float* rope; float* kpart;
    __device__ __forceinline__ void operator()(const f32x4 (&acc)[2][2][4][2], const Unit& u, int wr, int wc, int fr, int fq) const {
        const int pn = u.pn;
        const bool do_rope = (pn < 4) || (pn >= 6 && pn < 10);
        const bool is_q = (pn < 2) || (pn == 6) || (pn == 7);
        const bool do_silu = pn >= 12;
        const float sc = is_q ? QC2 : 1.f;
        const int row0 = u.pm * BM + wr * 64 + fr;
        const float sg = (fq == 0) ? -1.f : 1.f;
        const bool is_mk = (pn == 2) || (pn == 3);
        f32x4 cs0 = {0.f, 0.f, 0.f, 0.f}, cs1 = cs0, cs2 = cs0, cs3 = cs0;
#pragma unroll
        for (int ai = 0; ai < 2; ++ai)
#pragma unroll
            for (int m = 0; m < 4; ++m) {
                const int row = row0 + ai * HALF + m * 16;
                bf16_t* rowp = do_silu ? Z + (size_t)row * 1024 + (pn - 12) * 256 + wc * 64 + 8 * fq : O + ((size_t)(pn * 4 + wc) * 65536 + row) * 64 + 8 * fq;
                f32x4 v0 = acc[ai][0][m][0], v1 = acc[ai][0][m][1], w0 = acc[ai][1][m][0], w1 = acc[ai][1][m][1];
                if (do_rope) {
                    f32x4 c0 = {1.f, 1.f, 1.f, 1.f}, c1 = c0, s0 = {0.f, 0.f, 0.f, 0.f}, s1 = s0;
                    if (fq < 2) { const float* rp = rope + (row & 2047) * 16; c0 = *(const f32x4*)(rp); c1 = *(const f32x4*)(rp + 4); s0 = *(const f32x4*)(rp + 8) * sg; s1 = *(const f32x4*)(rp + 12) * sg; }
                    f32x4 p0, p1;
#pragma unroll
                    for (int e = 0; e < 4; ++e) { p0[e] = __shfl_xor(v0[e], 16); p1[e] = __shfl_xor(v1[e], 16); }
                    v0 = v0 * c0 + p0 * s0; v1 = v1 * c1 + p1 * s1;
                }
                if (do_silu) {
#pragma unroll
                    for (int e = 0; e < 4; ++e) { v0[e] = v0[e] * __builtin_amdgcn_rcpf(1.f + __expf(-v0[e])); v1[e] = v1[e] * __builtin_amdgcn_rcpf(1.f + __expf(-v1[e]));
                                                  w0[e] = w0[e] * __builtin_amdgcn_rcpf(1.f + __expf(-w0[e])); w1[e] = w1[e] * __builtin_amdgcn_rcpf(1.f + __expf(-w1[e])); }
                }
                if (is_mk) { cs0 += v0; cs1 += v1; cs2 += w0; cs3 += w1; }
                v0 = v0 * sc; v1 = v1 * sc; w0 = w0 * sc; w1 = w1 * sc;
                u32x4 a, b; a.x = cvt_pk_bf16(v0[0], v0[1]); a.y = cvt_pk_bf16(v0[2], v0[3]); a.z = cvt_pk_bf16(v1[0], v1[1]); a.w = cvt_pk_bf16(v1[2], v1[3]);
                b.x = cvt_pk_bf16(w0[0], w0[1]); b.y = cvt_pk_bf16(w0[2], w0[3]); b.z = cvt_pk_bf16(w1[0], w1[1]); b.w = cvt_pk_bf16(w1[2], w1[3]);
                __builtin_nontemporal_store(a, (u32x4*)(rowp)); __builtin_nontemporal_store(b, (u32x4*)(rowp + 32));
            }
        if (is_mk) {
#pragma unroll
            for (int e = 0; e < 4; ++e) {
#pragma unroll
                for (int o = 1; o < 16; o <<= 1) { cs0[e] += __shfl_xor(cs0[e], o); cs1[e] += __shfl_xor(cs1[e], o); cs2[e] += __shfl_xor(cs2[e], o); cs3[e] += __shfl_xor(cs3[e], o); } }
            if (fr == 0) { float* kp = kpart + ((size_t)u.pm * 2 + wr) * 512 + (pn - 2) * 256 + wc * 64 + 8 * fq;
                *(f32x4*)(kp) = cs0; *(f32x4*)(kp + 4) = cs1; *(f32x4*)(kp + 32) = cs2; *(f32x4*)(kp + 36) = cs3; }
        }
    }
};
typedef unsigned u32x2 __attribute__((ext_vector_type(2)));
struct EpiOut {
    static constexpr bool PERM = false, AFTER_DRAIN = false;
    const float* x; bf16_t* hb; float* part;
    __device__ __forceinline__ void operator()(const f32x4 (&acc)[2][2][4][2], const Unit& u, int wr, int wc, int fr, int fq) const {
        const int col0 = u.pn * BM + wc * 32 + 4 * fq;
#pragma unroll
        for (int ai = 0; ai < 2; ++ai) {
            f32x4 xv[4][2][2];
#pragma unroll
            for (int m = 0; m < 4; ++m) { const size_t off = (size_t)(u.pm * BM + ai * HALF + wr * 64 + m * 16 + fr) * 1024 + col0;
#pragma unroll
                for (int bj = 0; bj < 2; ++bj)
#pragma unroll
                    for (int n = 0; n < 2; ++n) xv[m][bj][n] = __builtin_nontemporal_load((const f32x4*)(x + off + bj * HALF + n * 16)); }
#pragma unroll
            for (int m = 0; m < 4; ++m) {
                const int r = u.pm * BM + ai * HALF + wr * 64 + m * 16 + fr; const size_t off = (size_t)r * 1024 + col0; float ss = 0.f;
#pragma unroll
                for (int bj = 0; bj < 2; ++bj)
#pragma unroll
                    for (int n = 0; n < 2; ++n) {
                        const f32x4 h = xv[m][bj][n] + acc[ai][bj][m][n];
                        ss += (h[0] * h[0] + h[1] * h[1]) + (h[2] * h[2] + h[3] * h[3]);
                        u32x2 w; w.x = cvt_pk_bf16(h[0], h[1]); w.y = cvt_pk_bf16(h[2], h[3]);
                        *(u32x2*)(hb + off + bj * HALF + n * 16) = w;
                    }
                ss += __shfl_xor(ss, 16); ss += __shfl_xor(ss, 32);
                if (fq == 0) part[(size_t)r * 16 + u.pn * 4 + wc] = ss;
            }
            asm volatile("" ::: "memory");
        }
    }
};
struct EpiGate {
    static constexpr bool PERM = false, AFTER_DRAIN = false;
    const bf16_t* hb; const bf16_t* pe; float* out; const float* part; float* part2; unsigned* cnt; const float* gfin;
    __device__ __forceinline__ void operator()(f32x4 (&acc)[2][2][4][2], const Unit& u, int wr, int wc, int fr, int fq) const {
        const int col0 = u.pn * BM + wc * 32 + 4 * fq;
        const int rbase = u.pm * BM + wr * 64 + fr;
        float rs[8];
        { f32x4 q[8];
#pragma unroll
          for (int k = 0; k < 8; ++k) q[k] = *(const f32x4*)(part + (size_t)(rbase + (k >> 2) * HALF + (k & 3) * 16) * 16 + 4 * fq);
#pragma unroll
          for (int k = 0; k < 8; ++k) { float t = (q[k][0] + q[k][1]) + (q[k][2] + q[k][3]); t += __shfl_xor(t, 16); t += __shfl_xor(t, 32); rs[k] = __builtin_amdgcn_rsqf(t * (1.f / 1024.f) + 1e-6f); } }
#pragma unroll
        for (int kp = 0; kp < 4; ++kp) { const int ai = kp >> 1;
            u32x2 hv[2][2][2], pv[2][2][2];
#pragma unroll
            for (int mm = 0; mm < 2; ++mm) { const int m = (kp & 1) * 2 + mm; const size_t off = (size_t)(rbase + ai * HALF + m * 16) * 1024 + col0;
#pragma unroll
                for (int bj = 0; bj < 2; ++bj)
#pragma unroll
                    for (int n = 0; n < 2; ++n) { hv[mm][bj][n] = *(const u32x2*)(hb + off + bj * HALF + n * 16); pv[mm][bj][n] = *(const u32x2*)(pe + off + bj * HALF + n * 16); } }
#pragma unroll
            for (int mm = 0; mm < 2; ++mm) { const int m = (kp & 1) * 2 + mm;
#pragma unroll
                for (int bj = 0; bj < 2; ++bj)
#pragma unroll
                    for (int n = 0; n < 2; ++n) {
                        const u32x2 hw = hv[mm][bj][n], pw = pv[mm][bj][n];
                        const f32x4 h = {__uint_as_float(hw.x << 16), __uint_as_float(hw.x & 0xffff0000u), __uint_as_float(hw.y << 16), __uint_as_float(hw.y & 0xffff0000u)};
                        const f32x4 p = {__uint_as_float(pw.x << 16), __uint_as_float(pw.x & 0xffff0000u), __uint_as_float(pw.y << 16), __uint_as_float(pw.y & 0xffff0000u)};
                        const f32x4 a = acc[ai][bj][m][n] * rs[ai * 4 + m]; f32x4 o;
#pragma unroll
                        for (int e = 0; e < 4; ++e) o[e] = h[e] + p[e] * __builtin_amdgcn_rcpf(1.f + __expf(-a[e]));
                        acc[ai][bj][m][n] = o;
                    } }
            asm volatile("" ::: "memory");
        }
        { float ssv[8];
#pragma unroll
          for (int k = 0; k < 8; ++k) { const int ai = k >> 2, m = k & 3; float ss = 0.f;
#pragma unroll
            for (int bj = 0; bj < 2; ++bj)
#pragma unroll
                for (int n = 0; n < 2; ++n) { const f32x4 h = acc[ai][bj][m][n]; ss += (h[0] * h[0] + h[1] * h[1]) + (h[2] * h[2] + h[3] * h[3]); }
            ss += __shfl_xor(ss, 16); ss += __shfl_xor(ss, 32); ssv[k] = ss; }
          if (fq == 0) {
#pragma unroll
            for (int k = 0; k < 8; ++k) __hip_atomic_store(part2 + (size_t)(rbase + (k >> 2) * HALF + (k & 3) * 16) * 16 + u.pn * 4 + wc, ssv[k], __ATOMIC_RELAXED, __HIP_MEMORY_SCOPE_AGENT); } }
        asm volatile("s_waitcnt vmcnt(0)" ::: "memory");
        unsigned* c = cnt + 64 * u.pm;
        if (fr == 0 && fq == 0) __hip_atomic_fetch_add(c, 1u, __ATOMIC_RELAXED, __HIP_MEMORY_SCOPE_AGENT);
        { unsigned sp = 0;
          while ((unsigned)__builtin_amdgcn_readfirstlane(__hip_atomic_load(c, __ATOMIC_RELAXED, __HIP_MEMORY_SCOPE_AGENT)) < 32u) { __builtin_amdgcn_s_sleep(8); if (++sp > (1u << 20)) break; } }
#pragma unroll
        for (int k = 0; k < 8; ++k) { const float* pp = part2 + (size_t)(rbase + (k >> 2) * HALF + (k & 3) * 16) * 16 + 4 * fq;
            const float t0 = __hip_atomic_load(pp, __ATOMIC_RELAXED, __HIP_MEMORY_SCOPE_AGENT), t1 = __hip_atomic_load(pp + 1, __ATOMIC_RELAXED, __HIP_MEMORY_SCOPE_AGENT),
                        t2 = __hip_atomic_load(pp + 2, __ATOMIC_RELAXED, __HIP_MEMORY_SCOPE_AGENT), t3 = __hip_atomic_load(pp + 3, __ATOMIC_RELAXED, __HIP_MEMORY_SCOPE_AGENT);
            float t = (t0 + t1) + (t2 + t3); t += __shfl_xor(t, 16); t += __shfl_xor(t, 32); rs[k] = __builtin_amdgcn_rsqf(t * (1.f / 1024.f) + 1e-6f); }
        f32x4 gf[2][2];
#pragma unroll
        for (int bj = 0; bj < 2; ++bj)
#pragma unroll
            for (int n = 0; n < 2; ++n) gf[bj][n] = *(const f32x4*)(gfin + col0 + bj * HALF + n * 16);
#pragma unroll
        for (int k = 0; k < 8; ++k) { const int ai = k >> 2, m = k & 3; const size_t off = (size_t)(rbase + ai * HALF + m * 16) * 1024 + col0;
#pragma unroll
            for (int bj = 0; bj < 2; ++bj)
#pragma unroll
                for (int n = 0; n < 2; ++n) __builtin_nontemporal_store(acc[ai][bj][m][n] * rs[k] * gf[bj][n], (f32x4*)(out + off + bj * HALF + n * 16)); }
    }
};

template <class Epi, class Sched, bool ALIGN_EPI = false, bool SP2 = false>
__device__ __forceinline__ void gemm_phase(PG8_LAS unsigned char* lds, const Gemm g, const Sched& S, const Epi& E, const int wave_s) {
    const int tid = tid_now(wave_s), wid = __builtin_amdgcn_readfirstlane(tid >> 6), lane = tid & 63, wr = wid >> 2, wc = wid & 3, fr = lane & 15, fq = lane >> 4;
    const int K = g.K, nt = K / BK;
    unsigned voffA[2], voffB[2];
#pragma unroll
    for (int i = 0; i < 2; ++i) { int R, C; stage_rc(tid * 16 + i * 8192, R, C); const int Rb = Epi::PERM ? ((R & ~31) + perm32(R & 31)) : R;
        voffA[i] = (unsigned)(R * K + C) * 2u; voffB[i] = (unsigned)(Rb * K + C) * 2u; }
    const size_t kstep = (size_t)(BK * 2);
    const size_t hstep = (size_t)HALF * K * 2;
    const size_t tstep = 2 * hstep;
    const unsigned ldsw = (unsigned)wid * 1024u;
    const int aoff = lds_byte(wr * 64 + fr, fq * 8), boff = lds_byte(wc * 32 + fr, fq * 8);
#define PG8_SA(b, h) (((b) * 2 + (h)) * HTB)
#define PG8_SB(b, h) ((4 + (b) * 2 + (h)) * HTB)
#define PG8_STAGE(bufoff, gbase, voff) do { _Pragma("unroll") for (int _i = 0; _i < 2; ++_i) \
        __builtin_amdgcn_global_load_lds((const unsigned*)((const char*)(gbase) + (voff)[_i]), (PG8_LAS unsigned*)(lds + (bufoff) + ldsw + _i * 8192), 16, 0, 0); } while (0)
#define PG8_LDA(dst, b, h) do { _Pragma("unroll") for (int m = 0; m < 4; ++m) _Pragma("unroll") for (int k = 0; k < 2; ++k) dst[m][k] = *(const PG8_LAS bf16x8*)(lds + PG8_SA(b, h) + aoff + m * 2048 + k * 1024); } while (0)
#define PG8_LDB(dst, b, h) do { _Pragma("unroll") for (int n = 0; n < 2; ++n) _Pragma("unroll") for (int k = 0; k < 2; ++k) dst[n][k] = *(const PG8_LAS bf16x8*)(lds + PG8_SB(b, h) + boff + n * 2048 + k * 1024); } while (0)
#define PG8_MMA(ai, bj, At, Bt) do { __builtin_amdgcn_s_setprio(1); _Pragma("unroll") for (int m = 0; m < 4; ++m) _Pragma("unroll") for (int n = 0; n < 2; ++n) _Pragma("unroll") for (int k = 0; k < 2; ++k) \
        acc[ai][bj][m][n] = __builtin_amdgcn_mfma_f32_16x16x32_bf16(Bt[n][k], At[m][k], acc[ai][bj][m][n], 0, 0, 0); __builtin_amdgcn_s_setprio(0); } while (0)
#define PG8_WAIT_V(n) asm volatile("s_waitcnt vmcnt(" #n ")" ::: "memory")
#define PG8_WAIT_L(n) asm volatile("s_waitcnt lgkmcnt(" #n ")" ::: "memory")
#define PG8_BAR __builtin_amdgcn_s_barrier()
#define PG8_SCHED __builtin_amdgcn_sched_barrier(0)
    Unit cur, nxt; int ui = 0;
    if (!S.next(0, cur)) return;
    f32x4 acc[2][2][4][2];
#pragma unroll
    for (int a = 0; a < 2; ++a)
#pragma unroll
        for (int b = 0; b < 2; ++b)
#pragma unroll
            for (int m = 0; m < 4; ++m)
#pragma unroll
                for (int n = 0; n < 2; ++n) acc[a][b][m][n] = (f32x4){0.f, 0.f, 0.f, 0.f};
    bf16x8 At[4][2], B0[2][2], B1[2][2];
    const char* cA = (const char*)g.A + (size_t)cur.pm * tstep; const char* cB = (const char*)g.Bt + (size_t)cur.pn * tstep;
    S.a_ready(cur);
    if constexpr (SP2) {
        PG8_STAGE(PG8_SB(0, 0), cB, voffB); PG8_STAGE(PG8_SB(0, 1), cB + hstep, voffB); PG8_STAGE(PG8_SA(0, 0), cA, voffA); PG8_STAGE(PG8_SA(0, 1), cA + hstep, voffA);
        if (wr == 1) PG8_BAR;
        PG8_WAIT_V(2); PG8_BAR;
        PG8_STAGE(PG8_SB(1, 0), cB + kstep, voffB); PG8_STAGE(PG8_SA(1, 0), cA + kstep, voffA); PG8_STAGE(PG8_SB(1, 1), cB + hstep + kstep, voffB);
        PG8_WAIT_V(6); PG8_BAR;
    } else {
        PG8_STAGE(PG8_SB(0, 0), cB, voffB); PG8_STAGE(PG8_SA(0, 0), cA, voffA); PG8_STAGE(PG8_SB(0, 1), cB + hstep, voffB); PG8_STAGE(PG8_SA(0, 1), cA + hstep, voffA);
        if (wr == 1) PG8_BAR;
        PG8_WAIT_V(4); PG8_BAR;
        PG8_STAGE(PG8_SB(1, 0), cB + kstep, voffB); PG8_STAGE(PG8_SA(1, 0), cA + kstep, voffA); PG8_STAGE(PG8_SB(1, 1), cB + hstep + kstep, voffB);
        PG8_WAIT_V(6); PG8_BAR;
    }
    for (;;) {
        const bool has_next = S.next(ui + 1, nxt);
        const char* nA = has_next ? (const char*)g.A + (size_t)nxt.pm * tstep : cA; const char* nB = has_next ? (const char*)g.Bt + (size_t)nxt.pn * tstep : cB;
        for (int t = 0; t < nt; t += 2) {
            const bool last = (t == nt - 2);
            const char* a1 = cA + (size_t)(t + 1) * kstep;
            const char* a2 = last ? nA : cA + (size_t)(t + 2) * kstep; const char* b2 = last ? nB : cB + (size_t)(t + 2) * kstep;
            const char* a3 = a2 + kstep; const char* b3 = b2 + kstep;
            if (last && has_next) S.a_ready(nxt);
            if constexpr (SP2) {
            PG8_LDB(B0, 0, 0); PG8_LDB(B1, 0, 1); PG8_SCHED; PG8_LDA(At, 0, 0); PG8_STAGE(PG8_SA(1, 1), a1 + hstep, voffA);
            PG8_WAIT_V(8); PG8_WAIT_L(0); PG8_BAR; PG8_MMA(0, 0, At, B0); PG8_MMA(0, 1, At, B1); PG8_BAR; PG8_SCHED;
            PG8_LDA(At, 0, 1); PG8_STAGE(PG8_SB(0, 0), b2, voffB); PG8_STAGE(PG8_SB(0, 1), b2 + hstep, voffB); PG8_STAGE(PG8_SA(0, 0), a2, voffA);
            PG8_WAIT_V(8); PG8_WAIT_L(0); PG8_BAR; PG8_MMA(1, 0, At, B0); PG8_MMA(1, 1, At, B1); PG8_BAR; PG8_SCHED;
            PG8_LDB(B0, 1, 0); PG8_LDB(B1, 1, 1); PG8_SCHED; PG8_LDA(At, 1, 0); PG8_STAGE(PG8_SA(0, 1), a2 + hstep, voffA);
            PG8_WAIT_V(8); PG8_WAIT_L(0); PG8_BAR; PG8_MMA(0, 0, At, B0); PG8_MMA(0, 1, At, B1); PG8_BAR; PG8_SCHED;
            PG8_LDA(At, 1, 1); PG8_STAGE(PG8_SB(1, 0), b3, voffB); PG8_STAGE(PG8_SB(1, 1), b3 + hstep, voffB); PG8_STAGE(PG8_SA(1, 0), a3, voffA);
            PG8_WAIT_V(8); PG8_WAIT_L(0); PG8_BAR; PG8_MMA(1, 0, At, B0); PG8_MMA(1, 1, At, B1); PG8_BAR; PG8_SCHED;
            } else {
            PG8_LDB(B0, 0, 0); PG8_SCHED; PG8_LDA(At, 0, 0); PG8_STAGE(PG8_SA(1, 1), a1 + hstep, voffA);
            PG8_WAIT_L(8); PG8_BAR; PG8_WAIT_L(0); PG8_MMA(0, 0, At, B0); PG8_BAR; PG8_SCHED;
            PG8_LDB(B1, 0, 1); PG8_STAGE(PG8_SB(0, 0), b2, voffB);
            PG8_BAR; PG8_WAIT_L(0); PG8_MMA(0, 1, At, B1); PG8_BAR;
            PG8_LDA(At, 0, 1); PG8_STAGE(PG8_SA(0, 0), a2, voffA);
            PG8_BAR; PG8_WAIT_L(0); PG8_MMA(1, 0, At, B0); PG8_BAR; PG8_SCHED;
            PG8_STAGE(PG8_SB(0, 1), b2 + hstep, voffB);
            PG8_WAIT_V(6); PG8_BAR; PG8_MMA(1, 1, At, B1); PG8_BAR;
            PG8_LDB(B0, 1, 0); PG8_SCHED; PG8_LDA(At, 1, 0); PG8_STAGE(PG8_SA(0, 1), a2 + hstep, voffA);
            PG8_WAIT_L(8); PG8_BAR; PG8_WAIT_L(0); PG8_MMA(0, 0, At, B0); PG8_BAR; PG8_SCHED;
            PG8_LDB(B1, 1, 1); PG8_STAGE(PG8_SB(1, 0), b3, voffB);
            PG8_BAR; PG8_WAIT_L(0); PG8_MMA(0, 1, At, B1); PG8_BAR;
            PG8_LDA(At, 1, 1); PG8_STAGE(PG8_SA(1, 0), a3, voffA);
            PG8_BAR; PG8_WAIT_L(0); PG8_MMA(1, 0, At, B0); PG8_BAR; PG8_SCHED;
            PG8_STAGE(PG8_SB(1, 1), b3 + hstep, voffB);
            PG8_WAIT_V(6); PG8_BAR; PG8_MMA(1, 1, At, B1); PG8_BAR;
            }
        }
        if constexpr (ALIGN_EPI) { if (wr == 0) PG8_BAR; }
        if constexpr (!Epi::AFTER_DRAIN) { E(acc, cur, wr, wc, fr, fq); S.done(cur); }
        if (!has_next) break;
#pragma unroll
        for (int a = 0; a < 2; ++a)
#pragma unroll
            for (int b = 0; b < 2; ++b)
#pragma unroll
                for (int m = 0; m < 4; ++m)
#pragma unroll
                    for (int n = 0; n < 2; ++n) acc[a][b][m][n] = (f32x4){0.f, 0.f, 0.f, 0.f};
        cur = nxt; cA = nA; cB = nB; ++ui;
        if constexpr (ALIGN_EPI) { if (wr == 1) PG8_BAR; }
    }
    PG8_WAIT_V(0);
    if constexpr (!ALIGN_EPI) { if (wr == 0) PG8_BAR; }
    PG8_BAR;
    if constexpr (Epi::AFTER_DRAIN) { E.fused(acc, cur, wr, wc, fr, fq, lds, wid, lane); S.done(cur); }
#undef PG8_SA
#undef PG8_SB
#undef PG8_STAGE
#undef PG8_LDA
#undef PG8_LDB
#undef PG8_MMA
#undef PG8_WAIT_V
#undef PG8_WAIT_L
#undef PG8_BAR
#undef PG8_SCHED
}
}

#ifndef PG8_SP2
#define PG8_SP2 true
#endif
#ifndef PG8_ALIGN
#define PG8_ALIGN true
#endif
#include <hip/hip_bf16.h>
#include <cmath>
namespace attn_body {
using bf16=__hip_bfloat16;
using bf16x8=__attribute__((ext_vector_type(8)))short;
using s16x4=__attribute__((ext_vector_type(4)))short;
using f32x16=__attribute__((ext_vector_type(16)))float;
using u32x4=__attribute__((ext_vector_type(4)))unsigned;
constexpr int SEQ=2048,D=64,PQ=64,MROWS=65536;
constexpr int NW=8,QBLK=32,QB=QBLK*NW,KVBLK=64,NQB=SEQ/QB;
constexpr int ATTN_UNIT_ROWS=QB;
__device__ __forceinline__ int crow(int r,int hi){return (r&3)+8*(r>>2)+4*hi;}
#define SBAR() __builtin_amdgcn_sched_barrier(0)
__device__ __forceinline__ void cmask(f32x16&p0,f32x16&p1,int jb,int qrel,int hi){
  const float NEG=-INFINITY; int d=qrel-64*jb-4*hi; asm volatile("":"+v"(d));
  #pragma unroll
  for(int r=0;r<16;++r){const int c=(r&3)+8*(r>>2); if(c>d)p0[r]=NEG; if(c+32>d)p1[r]=NEG;}
}

constexpr int NSLOT=3, SLOTB=8192;
constexpr int LDS_K=0, LDS_V=NSLOT*SLOTB, LDS_WS=3*NSLOT*SLOTB  , LDS_OST=LDS_WS+NW*64*4, LDS_BYTES=LDS_OST+NW*4096;
constexpr float C2=0.125f*1.4426950408889634f;
__device__ __forceinline__ void glds16(const void*gsrc,unsigned lds_dst){unsigned keep;
  asm volatile("s_mov_b32 %0, m0\n\ts_mov_b32 m0, %2\n\ts_nop 0\n\tglobal_load_lds_dwordx4 %1, off\n\ts_mov_b32 m0, %0":"=&s"(keep):"v"(gsrc),"s"(lds_dst):"memory");}
__device__ __forceinline__ void glds16s(const void*sbase,unsigned voff,unsigned lds_dst){unsigned keep;
  asm volatile("s_mov_b32 %0, m0\n\ts_mov_b32 m0, %2\n\ts_nop 0\n\tglobal_load_lds_dwordx4 %1, %3\n\ts_mov_b32 m0, %0":"=&s"(keep):"v"(voff),"s"(lds_dst),"s"(sbase):"memory");}
__device__ __forceinline__ float max3f(float a,float b,float c){float r;asm("v_max3_f32 %0, %1, %2, %3":"=v"(r):"v"(a),"v"(b),"v"(c));return r;}
__device__ __forceinline__ float max2f(float a,float b){float r;asm("v_max_f32_e32 %0, %1, %2":"=v"(r):"v"(a),"v"(b));return r;}
__device__ __forceinline__ float fadd_s(float a,float b){float r;asm("v_add_f32_e32 %0, %1, %2":"=v"(r):"v"(a),"v"(b));return r;}
__device__ __forceinline__ float fsub_s(float a,float b){float r;asm("v_sub_f32_e32 %0, %1, %2":"=v"(r):"v"(a),"v"(b));return r;}
typedef float f32x4_t __attribute__((ext_vector_type(4))); typedef float f32x2_t __attribute__((ext_vector_type(2))); typedef __bf16 bf16x2_t __attribute__((ext_vector_type(2)));
__device__ __forceinline__ unsigned cvtpk_s(float lo,float hi){f32x2_t v={lo,hi};bf16x2_t b=__builtin_convertvector(v,bf16x2_t);return __builtin_bit_cast(unsigned,b);}
#define WAIT_BAR(N) asm volatile("s_waitcnt vmcnt(" #N ") lgkmcnt(0)\n\ts_barrier":::"memory")

__device__ __forceinline__ void qkt(f32x16&p0,f32x16&p1,const char*Kslot,const bf16x8*qr,const f32x16&negm,int r32,int hi){
  const char*kb=Kslot+hi*1024+r32*16;
  #pragma unroll
  for(int d0=0;d0<4;++d0){
    const bf16x8 b0=*reinterpret_cast<const bf16x8*>(kb+d0*2048);
    const bf16x8 b1=*reinterpret_cast<const bf16x8*>(kb+d0*2048+512);
    if(d0==0){p0=__builtin_amdgcn_mfma_f32_32x32x16_bf16(b0,qr[0],negm,0,0,0);p1=__builtin_amdgcn_mfma_f32_32x32x16_bf16(b1,qr[0],negm,0,0,0);}
    else{p0=__builtin_amdgcn_mfma_f32_32x32x16_bf16(b0,qr[d0],p0,0,0,0);p1=__builtin_amdgcn_mfma_f32_32x32x16_bf16(b1,qr[d0],p1,0,0,0);}}
}
typedef __attribute__((address_space(3))) const char* lds_cptr;
typedef short v4i16_t __attribute__((ext_vector_type(4)));
__device__ __forceinline__ void kload8(bf16x8*kf,lds_cptr kp){
  kf[0]=*(const __attribute__((address_space(3))) bf16x8*)(kp);      kf[1]=*(const __attribute__((address_space(3))) bf16x8*)(kp+512);
  kf[2]=*(const __attribute__((address_space(3))) bf16x8*)(kp+2048); kf[3]=*(const __attribute__((address_space(3))) bf16x8*)(kp+2560);
  kf[4]=*(const __attribute__((address_space(3))) bf16x8*)(kp+4096); kf[5]=*(const __attribute__((address_space(3))) bf16x8*)(kp+4608);
  kf[6]=*(const __attribute__((address_space(3))) bf16x8*)(kp+6144); kf[7]=*(const __attribute__((address_space(3))) bf16x8*)(kp+6656);
}
__device__ __forceinline__ void kload2(bf16x8*kf,lds_cptr kp,int j){ kf[2*j]=*(const __attribute__((address_space(3))) bf16x8*)(kp+j*2048); kf[2*j+1]=*(const __attribute__((address_space(3))) bf16x8*)(kp+j*2048+512); }
__device__ __forceinline__ s16x4 vtr(lds_cptr p){ return __builtin_bit_cast(s16x4,__builtin_amdgcn_ds_read_tr16_b64_v4i16((__attribute__((address_space(3))) v4i16_t*)p)); }
__device__ __forceinline__ float rowmax(const f32x16&p0,const f32x16&p1){
  float a=max3f(p0[0],p0[1],p1[0]),b=max3f(p0[2],p0[3],p1[1]);a=max3f(a,p1[2],p1[3]);
  #pragma unroll
  for(int r=4;r<16;r+=4){a=max3f(a,p0[r],p0[r+1]);b=max3f(b,p0[r+2],p0[r+3]);a=max3f(a,p1[r],p1[r+1]);b=max3f(b,p1[r+2],p1[r+3]);}
  const float m=max2f(a,b);
  auto rr=__builtin_amdgcn_permlane32_swap(__float_as_uint(m),__float_as_uint(m),false,false);
  return max2f(__uint_as_float(rr[0]),__uint_as_float(rr[1]));
}
__device__ __forceinline__ void pv(f32x16*o,int vb,bf16x8 pa0,bf16x8 pa1,bf16x8 pa2,bf16x8 pa3){
  #pragma unroll
  for(int d0=0;d0<2;++d0){s16x4 lo[4],hi[4];
    #pragma unroll
    for(int ks=0;ks<4;++ks){
      asm volatile("ds_read_b64_tr_b16 %0,%1 offset:%c2":"=&v"(lo[ks]):"v"(vb),"i"(d0*4096+ks*1024):"memory");
      asm volatile("ds_read_b64_tr_b16 %0,%1 offset:%c2":"=&v"(hi[ks]):"v"(vb),"i"(d0*4096+ks*1024+512):"memory");}
    asm volatile("s_waitcnt lgkmcnt(0)":::"memory");SBAR();
    #define PK(k) (bf16x8){lo[k][0],lo[k][1],lo[k][2],lo[k][3],hi[k][0],hi[k][1],hi[k][2],hi[k][3]}
    o[d0]=__builtin_amdgcn_mfma_f32_32x32x16_bf16(pa0,PK(0),o[d0],0,0,0);
    o[d0]=__builtin_amdgcn_mfma_f32_32x32x16_bf16(pa1,PK(1),o[d0],0,0,0);
    o[d0]=__builtin_amdgcn_mfma_f32_32x32x16_bf16(pa2,PK(2),o[d0],0,0,0);
    o[d0]=__builtin_amdgcn_mfma_f32_32x32x16_bf16(pa3,PK(3),o[d0],0,0,0);
    #undef PK
  }
}

#ifndef ATTN_STORE16
#define ATTN_STORE16(p,v) (*(u32x4*)(p)=(v))
#endif
__device__ __forceinline__ void attn_prefetch(const bf16*Qh,const bf16*Kh,int qb,bf16x8(&qn)[4],char*shm,const int wave_s){
  const int tid=tid_now(wave_s),lane=tid&63,r32=lane&31,hi=lane>>5; const int wid=__builtin_amdgcn_readfirstlane(tid>>6);
  const unsigned lds0=(unsigned)(uintptr_t)shm; const unsigned koff=(unsigned)((lane*PQ+wid*8)*2); const unsigned kdst=lds0+LDS_K+wid*1024;
  glds16s(Kh,koff,(unsigned)__builtin_amdgcn_readfirstlane(kdst)); glds16s(Kh+(long)KVBLK*PQ,koff,(unsigned)__builtin_amdgcn_readfirstlane(kdst+SLOTB)); glds16s(Kh+(long)2*KVBLK*PQ,koff,(unsigned)__builtin_amdgcn_readfirstlane(kdst+2*SLOTB));
  const char*Qw=(const char*)(Qh+(long)(qb*QB+wid*QBLK)*PQ); const unsigned qoff=(unsigned)((r32*PQ+hi*8)*2);
  #pragma unroll
  for(int d0=0;d0<4;++d0)qn[d0]=*reinterpret_cast<const bf16x8*>(Qw+qoff+d0*32);
}
struct EpiArgs { int mode; bf16* out; const bf16* z; const bf16* od; const float* gsub; const float* lq1; const float* lk1; const float* lq2; const float* lk2; };
template<int THRL,bool WIDE> __device__ __forceinline__ void attn_unit(int qb,bf16x8(&qr)[4],const bf16*__restrict__ Kh,const bf16*__restrict__ Vh,const EpiArgs EA,const float*kmean,const bool has_next,const bf16*Qn,const bf16*Kn,int qbn,char*shm,const int wave_s){
  const int tid=tid_now(wave_s),lane=tid&63,r32=lane&31,hi=lane>>5; const int wid=__builtin_amdgcn_readfirstlane(tid>>6);
  constexpr bool MOBA=!WIDE;
  const int q0=qb*QB;
  const unsigned lds0=(unsigned)(uintptr_t)shm;
  float*wsf=(float*)(shm+LDS_WS)+wid*64;
  const unsigned koff=(unsigned)((lane*PQ+wid*8)*2);
  const unsigned voff=(unsigned)(((16*(wid&3)+(lane>>2))*PQ+(wid>>2)*32+(lane&3)*8)*2);
  const unsigned kdst=lds0+LDS_K+wid*1024, vdst=lds0+LDS_V+wid*1024;
  #define DMA_K(t,slot) glds16s(Kh+(long)(t)*KVBLK*PQ,koff,(unsigned)__builtin_amdgcn_readfirstlane(kdst+(slot)))
  #define DMA_V(t,slot) do{ glds16s(Vh+(long)(t)*KVBLK*PQ,voff,(unsigned)__builtin_amdgcn_readfirstlane(vdst+2*(slot))); \
    if constexpr(WIDE) glds16s(Vh+(long)MROWS*64+(long)(t)*KVBLK*PQ,voff,(unsigned)__builtin_amdgcn_readfirstlane(vdst+2*(slot)+8192)); }while(0)
  #define WB(a,b) do{ if constexpr(WIDE){WAIT_BAR(b);} else {WAIT_BAR(a);} }while(0)
  const int vb0=(int)(lds0+LDS_V)+((lane>>4)&1)*32+(lane&3)*8+(4*hi+((lane&15)>>2))*64;
  const char*Kbase=shm+LDS_K; bf16x8 kf[8];
  const lds_cptr shm3=(lds_cptr)shm; const lds_cptr kp0=shm3+LDS_K+hi*1024+r32*16; const lds_cptr vp0=shm3+LDS_V+((lane>>4)&1)*32+(lane&3)*8+(4*hi+((lane&15)>>2))*64;
  const int NT=(q0+QB)/KVBLK;
  DMA_V(0,0);

  unsigned selmask=0xffu;
  if(MOBA && qb>=4){
    float g[7]; int hio=hi; asm volatile("":"+v"(hio));
    #pragma unroll
    for(int blk=0;blk<7;++blk){ float s=-INFINITY;
      if(blk<qb){ const float*km=kmean+blk*1024+hio*8; float a=0.f;
        #pragma unroll
        for(int d0=0;d0<4;++d0){ const f32x4_t ka=*reinterpret_cast<const f32x4_t*>(km+d0*16)+*reinterpret_cast<const f32x4_t*>(km+512+d0*16), kb2=*reinterpret_cast<const f32x4_t*>(km+d0*16+4)+*reinterpret_cast<const f32x4_t*>(km+512+d0*16+4);
          #pragma unroll
          for(int e=0;e<4;++e){ a+=__uint_as_float(((unsigned)(unsigned short)qr[d0][e])<<16)*ka[e]; a+=__uint_as_float(((unsigned)(unsigned short)qr[d0][4+e])<<16)*kb2[e]; } }
        s=a+__shfl_xor(a,32); }
      g[blk]=s; }
    selmask=1u<<qb;
    #pragma unroll
    for(int blk=0;blk<7;++blk){ int rank=0;
      #pragma unroll
      for(int b2=0;b2<7;++b2){ if(b2!=blk) rank+=((g[b2]>g[blk])||(g[b2]==g[blk]&&b2<blk))?1:0; }
      if(blk<qb&&rank<3) selmask|=1u<<blk; }
  }
  #define BMASK(P0,P1,t) do{ if(MOBA && (t)<NT-4){ if(!((selmask>>((t)>>2))&1u)){ _Pragma("unroll") for(int r_=0;r_<16;++r_){P0[r_]=-INFINITY;P1[r_]=-INFINITY;} } } }while(0)
  float mhat=0.f,l_reg=0.f;constexpr int NO=WIDE?4:2; f32x16 o[NO];
  #pragma unroll
  for(int d_=0;d_<NO;++d_)o[d_]=f32x16{};
  const f32x16 negm=f32x16{};
  const int qrel=wid*QBLK+r32;
  #define CMASK(P0,P1,t) do{int jb_=(t)-(NT-4); if(jb_>=0)cmask(P0,P1,jb_,qrel,hi); else BMASK(P0,P1,t);}while(0)
  bool resc=false;
  #define START(P0,P1) do{ const float rm=rowmax(P0,P1); resc=false; \
    { const float dl=MOBA?__builtin_fmaxf(rm,-1000.f):rm; mhat=fadd_s(mhat,dl); \
      _Pragma("unroll") for(int r=0;r<16;++r){P0[r]=fsub_s(P0[r],dl);P1[r]=fsub_s(P1[r],dl);} \
      } \
    _Pragma("unroll") for(int r=0;r<16;++r)P0[r]=__builtin_amdgcn_exp2f(P0[r]); }while(0)
  #define RESC() do{ if(resc){ asm volatile("s_waitcnt lgkmcnt(0)":::"memory"); \
      _Pragma("unroll") for(int d_=0;d_<NO;++d_) _Pragma("unroll") for(int r=0;r<16;++r)o[d_][r]*=wsb[(r&3)+8*(r>>2)]; } }while(0)
  typedef __attribute__((address_space(3))) const float* lds_fptr; const lds_fptr wsb=(lds_fptr)(shm3+LDS_WS)+wid*64+4*hi;
  f32x16 pA0,pA1,pB0,pB1; u32x4 pw0,pw1,pw2,pw3;
  u32x4 qw0,qw1,qw2,qw3; float sacc_c=0.f;
  int sl_prev=0,sl_cur=0,sl_next=SLOTB;
  #define ROT() do{sl_prev=sl_cur;sl_cur=sl_next;sl_next=(sl_next==(NSLOT-1)*SLOTB)?0:sl_next+SLOTB;}while(0)
  WB(1,2);
  qkt(pA0,pA1,Kbase,qr,negm,r32,hi);asm volatile("s_nop 15\n\ts_nop 7":"+v"(pA0),"+v"(pA1));CMASK(pA0,pA1,0);
  START(pA0,pA1);
  _Pragma("unroll") for(int r=0;r<16;++r)pA1[r]=__builtin_amdgcn_exp2f(pA1[r]);
  if constexpr(WIDE){ float s0_=pA0[0]+pA0[1]; _Pragma("unroll") for(int r=2;r<16;++r)s0_+=pA0[r]; _Pragma("unroll") for(int r=0;r<16;++r)s0_+=pA1[r]; sacc_c=s0_;
    pw0=(u32x4){cvtpk_s(pA0[0],pA0[1]),cvtpk_s(pA0[2],pA0[3]),cvtpk_s(pA0[4],pA0[5]),cvtpk_s(pA0[6],pA0[7])};pw1=(u32x4){cvtpk_s(pA0[8],pA0[9]),cvtpk_s(pA0[10],pA0[11]),cvtpk_s(pA0[12],pA0[13]),cvtpk_s(pA0[14],pA0[15])};
    pw2=(u32x4){cvtpk_s(pA1[0],pA1[1]),cvtpk_s(pA1[2],pA1[3]),cvtpk_s(pA1[4],pA1[5]),cvtpk_s(pA1[6],pA1[7])};pw3=(u32x4){cvtpk_s(pA1[8],pA1[9]),cvtpk_s(pA1[10],pA1[11]),cvtpk_s(pA1[12],pA1[13]),cvtpk_s(pA1[14],pA1[15])}; }
  WAIT_BAR(0);
  DMA_K(3,0);DMA_V(1,SLOTB);
  ROT();
  kload8(kf,kp0+sl_cur);
  WB(2,3);
  s16x4 vlo[8],vhi[8];
  #define PKW(P,B) cvtpk_s(P[B],P[B+1])
  #define PAF(k) __builtin_bit_cast(bf16x8,pw##k)
  #define PAFX(S,k) __builtin_bit_cast(bf16x8,S##k)
  #define SP(X,B,PW,c) do{ sacc_c+=X[B]; sacc_c+=X[B+1]; PW[c]=PKW(X,B); PIN(sacc_c); PIN(PW); }while(0)
  #define GW(MF,X,B,SPX) do{ MF; X[B]=EX(X[B]); X[B+1]=EX(X[B+1]); SPX; SBAR(); }while(0)
  #define VFR(i) (bf16x8){vlo[i][0],vlo[i][1],vlo[i][2],vlo[i][3],vhi[i][0],vhi[i][1],vhi[i][2],vhi[i][3]}
  #define PIN(x) asm volatile("":"+v"(x))
  #define MX3(a,b,c) __builtin_fmaxf(__builtin_fmaxf((a),(b)),(c))
  #define GAPA(MF,A0,A1,A2,A3,W0,W1,PW) do{ MF; sacc+=A0; sacc+=A1; sacc+=A2; sacc+=A3; PIN(sacc); W0; W1; PIN(PW); SBAR(); }while(0)
  #define EX(v) __builtin_amdgcn_exp2f(v)
  #define GAPB(MF,X,B) do{ MF; X[B]=EX(X[B]); X[B+1]=EX(X[B+1]); X[B+2]=EX(X[B+2]); X[B+3]=EX(X[B+3]); PIN(X); SBAR(); }while(0)
  #define VRD(i) do{ vlo[i]=vtr(vp_+(((i)>>2)*4096+((i)&3)*1024)); vhi[i]=vtr(vp_+(((i)>>2)*4096+((i)&3)*1024+512)); }while(0)
  #define KRD(G,j) do{ if(G){ kload2(kf,kp0+sl_next,j); SBAR(); } }while(0)
  #define VRD2(i) do{ if constexpr(WIDE){ vlo[i]=vtr(vp_+8192+(((i)>>2)*4096+((i)&3)*1024)); vhi[i]=vtr(vp_+8192+(((i)>>2)*4096+((i)&3)*1024+512)); SBAR(); } }while(0)
  #define STEP(C0,C1,P0,P1,t,GK,GV,GL,PWC,PWN) do{ SBAR(); \
    const lds_cptr vp_=vp0+2*sl_prev; \
    float sacc=0.f; if constexpr(!WIDE) sacc=(P0[0]+P0[1]); \
    if constexpr(WIDE){   \
      VRD(0); SBAR(); C0=__builtin_amdgcn_mfma_f32_32x32x16_bf16(kf[0],qr[0],negm,0,0,0); SBAR(); \
      VRD(4); SBAR(); C1=__builtin_amdgcn_mfma_f32_32x32x16_bf16(kf[1],qr[0],negm,0,0,0); SBAR(); \
      VRD(1); SBAR(); C0=__builtin_amdgcn_mfma_f32_32x32x16_bf16(kf[2],qr[1],C0,0,0,0); SBAR(); \
      VRD(5); SBAR(); C1=__builtin_amdgcn_mfma_f32_32x32x16_bf16(kf[3],qr[1],C1,0,0,0); SBAR(); \
      VRD(2); SBAR(); C0=__builtin_amdgcn_mfma_f32_32x32x16_bf16(kf[4],qr[2],C0,0,0,0); SBAR(); \
      VRD(6); SBAR(); C1=__builtin_amdgcn_mfma_f32_32x32x16_bf16(kf[5],qr[2],C1,0,0,0); SBAR(); \
      VRD(3); SBAR(); C0=__builtin_amdgcn_mfma_f32_32x32x16_bf16(kf[6],qr[3],C0,0,0,0); SBAR(); \
      VRD(7); SBAR(); C1=__builtin_amdgcn_mfma_f32_32x32x16_bf16(kf[7],qr[3],C1,0,0,0); SBAR(); \
    } else { \
    VRD(0); SBAR(); \
    GAPA(C0=__builtin_amdgcn_mfma_f32_32x32x16_bf16(kf[0],qr[0],negm,0,0,0), P0[2],P0[3],P0[4],P0[5],     pw0[0]=PKW(P0,0), pw0[1]=PKW(P0,2), pw0); \
    VRD(4); SBAR(); GAPA(C1=__builtin_amdgcn_mfma_f32_32x32x16_bf16(kf[1],qr[0],negm,0,0,0), P0[6],P0[7],P0[8],P0[9],     pw0[2]=PKW(P0,4), pw0[3]=PKW(P0,6), pw0); \
    VRD(1); SBAR(); GAPA(C0=__builtin_amdgcn_mfma_f32_32x32x16_bf16(kf[2],qr[1],C0,0,0,0),   P0[10],P0[11],P0[12],P0[13], pw1[0]=PKW(P0,8), pw1[1]=PKW(P0,10), pw1); \
    VRD(5); SBAR(); GAPA(C1=__builtin_amdgcn_mfma_f32_32x32x16_bf16(kf[3],qr[1],C1,0,0,0),   P0[14],P0[15],P1[0],P1[1],   pw1[2]=PKW(P0,12),pw1[3]=PKW(P0,14), pw1); \
    VRD(2); SBAR(); GAPA(C0=__builtin_amdgcn_mfma_f32_32x32x16_bf16(kf[4],qr[2],C0,0,0,0),   P1[2],P1[3],P1[4],P1[5],     pw2[0]=PKW(P1,0), pw2[1]=PKW(P1,2), pw2); \
    VRD(6); SBAR(); GAPA(C1=__builtin_amdgcn_mfma_f32_32x32x16_bf16(kf[5],qr[2],C1,0,0,0),   P1[6],P1[7],P1[8],P1[9],     pw2[2]=PKW(P1,4), pw2[3]=PKW(P1,6), pw2); \
    VRD(3); SBAR(); GAPA(C0=__builtin_amdgcn_mfma_f32_32x32x16_bf16(kf[6],qr[3],C0,0,0,0),   P1[10],P1[11],P1[12],P1[13], pw3[0]=PKW(P1,8), pw3[1]=PKW(P1,10), pw3); \
    VRD(7); SBAR(); GAPA(C1=__builtin_amdgcn_mfma_f32_32x32x16_bf16(kf[7],qr[3],C1,0,0,0),   P1[14],P1[15],0.f,0.f,       pw3[2]=PKW(P1,12),pw3[3]=PKW(P1,14), pw3); \
    } \
    if constexpr(WIDE){ l_reg+=sacc_c; sacc_c=0.f; } else { l_reg+=sacc; } \
    if(GK){DMA_K((t)+3,sl_cur);} if(GV){DMA_V((t)+1,sl_next);} \
    CMASK(C0,C1,t); \
    _Pragma("unroll") for(int r=0;r<16;++r){C0[r]-=mhat;C1[r]-=mhat;} \
    { float a=MX3(C0[0],C0[1],C1[0]),b=MX3(C0[2],C0[3],C1[1]); a=MX3(a,C1[2],C1[3]); \
      _Pragma("unroll") for(int r=4;r<16;r+=4){a=MX3(a,C0[r],C0[r+1]);b=MX3(b,C0[r+2],C0[r+3]);a=MX3(a,C1[r],C1[r+1]);b=MX3(b,C1[r+2],C1[r+3]);} \
      float rm=__builtin_fmaxf(a,b); { auto rr=__builtin_amdgcn_permlane32_swap(__float_as_uint(rm),__float_as_uint(rm),false,false); rm=__builtin_fmaxf(__uint_as_float(rr[0]),__uint_as_float(rr[1])); } \
      resc=false; \
      if(__builtin_expect(__any(rm>(float)THRL),0)){ const float dl=__builtin_fmaxf(rm,0.f); mhat+=dl; \
        _Pragma("unroll") for(int r=0;r<16;++r){C0[r]-=dl;C1[r]-=dl;} \
        const float f=__builtin_amdgcn_exp2f(-dl); l_reg*=f; if(hi==0)wsf[r32]=f; resc=true; } } \
    SBAR(); \
    if constexpr(WIDE){ \
      GW(o[0]=__builtin_amdgcn_mfma_f32_32x32x16_bf16(PAFX(PWC,0),VFR(0),o[0],0,0,0), C0,0,  (void)0); VRD2(0); \
      GW(o[1]=__builtin_amdgcn_mfma_f32_32x32x16_bf16(PAFX(PWC,0),VFR(4),o[1],0,0,0), C0,4,  SP(C0,0,PWN##0,0)); VRD2(4); \
      GW(o[0]=__builtin_amdgcn_mfma_f32_32x32x16_bf16(PAFX(PWC,1),VFR(1),o[0],0,0,0), C0,8,  SP(C0,4,PWN##0,2)); VRD2(1); \
      GW(o[1]=__builtin_amdgcn_mfma_f32_32x32x16_bf16(PAFX(PWC,1),VFR(5),o[1],0,0,0), C0,12, SP(C0,8,PWN##1,0)); VRD2(5); \
      GW(o[0]=__builtin_amdgcn_mfma_f32_32x32x16_bf16(PAFX(PWC,2),VFR(2),o[0],0,0,0), C1,0,  SP(C0,12,PWN##1,2)); VRD2(2); \
      GW(o[1]=__builtin_amdgcn_mfma_f32_32x32x16_bf16(PAFX(PWC,2),VFR(6),o[1],0,0,0), C1,4,  SP(C1,0,PWN##2,0)); VRD2(6); \
      GW(o[0]=__builtin_amdgcn_mfma_f32_32x32x16_bf16(PAFX(PWC,3),VFR(3),o[0],0,0,0), C1,8,  SP(C1,4,PWN##2,2)); VRD2(3); \
      GW(o[1]=__builtin_amdgcn_mfma_f32_32x32x16_bf16(PAFX(PWC,3),VFR(7),o[1],0,0,0), C1,12, SP(C1,8,PWN##3,0)); VRD2(7); \
        \
      GW(o[2]=__builtin_amdgcn_mfma_f32_32x32x16_bf16(PAFX(PWC,0),VFR(0),o[2],0,0,0), C0,2,  SP(C1,12,PWN##3,2)); \
      GW(o[3]=__builtin_amdgcn_mfma_f32_32x32x16_bf16(PAFX(PWC,0),VFR(4),o[3],0,0,0), C0,6,  SP(C0,2,PWN##0,1)); \
      KRD(GL,0); GW(o[2]=__builtin_amdgcn_mfma_f32_32x32x16_bf16(PAFX(PWC,1),VFR(1),o[2],0,0,0), C0,10, SP(C0,6,PWN##0,3)); \
      KRD(GL,1); GW(o[3]=__builtin_amdgcn_mfma_f32_32x32x16_bf16(PAFX(PWC,1),VFR(5),o[3],0,0,0), C0,14, SP(C0,10,PWN##1,1)); \
      KRD(GL,2); GW(o[2]=__builtin_amdgcn_mfma_f32_32x32x16_bf16(PAFX(PWC,2),VFR(2),o[2],0,0,0), C1,2,  SP(C0,14,PWN##1,3)); \
      KRD(GL,3); GW(o[3]=__builtin_amdgcn_mfma_f32_32x32x16_bf16(PAFX(PWC,2),VFR(6),o[3],0,0,0), C1,6,  SP(C1,2,PWN##2,1)); \
      GW(o[2]=__builtin_amdgcn_mfma_f32_32x32x16_bf16(PAFX(PWC,3),VFR(3),o[2],0,0,0), C1,10, SP(C1,6,PWN##2,3)); \
      GW(o[3]=__builtin_amdgcn_mfma_f32_32x32x16_bf16(PAFX(PWC,3),VFR(7),o[3],0,0,0), C1,14, SP(C1,10,PWN##3,1)); \
      SP(C1,14,PWN##3,3); SBAR(); \
    } else { \
    GAPB(o[0]=__builtin_amdgcn_mfma_f32_32x32x16_bf16(PAF(0),VFR(0),o[0],0,0,0), C0,0); VRD2(0); \
    GAPB(o[1]=__builtin_amdgcn_mfma_f32_32x32x16_bf16(PAF(0),VFR(4),o[1],0,0,0), C0,4); VRD2(4); \
    KRD(GL,0); GAPB(o[0]=__builtin_amdgcn_mfma_f32_32x32x16_bf16(PAF(1),VFR(1),o[0],0,0,0), C0,8); VRD2(1); \
    KRD(GL,1); GAPB(o[1]=__builtin_amdgcn_mfma_f32_32x32x16_bf16(PAF(1),VFR(5),o[1],0,0,0), C0,12); VRD2(5); \
    KRD(GL,2); GAPB(o[0]=__builtin_amdgcn_mfma_f32_32x32x16_bf16(PAF(2),VFR(2),o[0],0,0,0), C1,0); VRD2(2); \
    KRD(GL,3); GAPB(o[1]=__builtin_amdgcn_mfma_f32_32x32x16_bf16(PAF(2),VFR(6),o[1],0,0,0), C1,4); VRD2(6); \
    GAPB(o[0]=__builtin_amdgcn_mfma_f32_32x32x16_bf16(PAF(3),VFR(3),o[0],0,0,0), C1,8); VRD2(3); \
    GAPB(o[1]=__builtin_amdgcn_mfma_f32_32x32x16_bf16(PAF(3),VFR(7),o[1],0,0,0), C1,12); VRD2(7); \
    } \
    }while(0)
  int t=1;
  #undef CMASK
  #define CMASK(P0,P1,t) BMASK(P0,P1,t)
  for(;t+5<NT;t+=2){
    STEP(pB0,pB1,pA0,pA1,t,true,true,true,pw,qw);     WB(2,3); RESC(); ROT();
    STEP(pA0,pA1,pB0,pB1,t+1,true,true,true,qw,pw);   WB(2,3); RESC(); ROT();
  }
  #undef CMASK
  #define CMASK(P0,P1,t) do{int jb_=(t)-(NT-4); if(jb_>=0)cmask(P0,P1,jb_,qrel,hi); else BMASK(P0,P1,t);}while(0)
  #define ENDW(tt) do{ if((tt)+3<NT){WB(2,3);} else if((tt)+2<NT){WB(1,2);} else {WAIT_BAR(0);} }while(0)
  for(;t+1<NT;t+=2){
    STEP(pB0,pB1,pA0,pA1,t,(t+3<NT),(t+1<NT),(t+1<NT),pw,qw);       ENDW(t);   RESC(); ROT();
    STEP(pA0,pA1,pB0,pB1,t+1,(t+4<NT),(t+2<NT),(t+2<NT),qw,pw);     ENDW(t+1); RESC(); ROT();
  }
  STEP(pB0,pB1,pA0,pA1,NT-1,false,false,false,pw,qw); RESC();
  int le=lane; asm volatile("":"+v"(le)); const int r32e=le&31,hie=le>>5;
  if(has_next) attn_prefetch(Qn,Kn,qbn,qr,shm,wave_s);
  const long orow0=(long)(q0+wid*QBLK)*1024;
  u32x4 pz[4][2],po[4][2];
  #pragma unroll
  for(int i=0;i<4;++i){ pz[i][0]=u32x4{};pz[i][1]=u32x4{};po[i][0]=u32x4{};po[i][1]=u32x4{}; }
  if(EA.mode!=1){
    #pragma unroll
    for(int i=0;i<4;++i){ const bf16*zp=EA.z+orow0+(long)(i*8+(le>>3))*1024+(le&7)*8; pz[i][0]=*(const u32x4*)(zp); if(EA.mode==2)pz[i][1]=*(const u32x4*)(zp+64); }
    if(EA.mode==2){
      #pragma unroll
      for(int i=0;i<4;++i){ const bf16*odp=EA.od+orow0+(long)(i*8+(le>>3))*1024+(le&7)*8; po[i][0]=*(const u32x4*)(odp); po[i][1]=*(const u32x4*)(odp+64); } }
  }
  if constexpr(WIDE){ l_reg+=sacc_c; SBAR(); pv(o,vb0+2*sl_cur,PAFX(qw,0),PAFX(qw,1),PAFX(qw,2),PAFX(qw,3)); pv(o+2,vb0+2*sl_cur+8192,PAFX(qw,0),PAFX(qw,1),PAFX(qw,2),PAFX(qw,3)); }
  else
  { float sacc=pB0[0]+pB0[1]; _Pragma("unroll") for(int r=2;r<16;++r)sacc+=pB0[r]; _Pragma("unroll") for(int r=0;r<16;++r)sacc+=pB1[r]; l_reg+=sacc;
    pw0=(u32x4){PKW(pB0,0),PKW(pB0,2),PKW(pB0,4),PKW(pB0,6)};pw1=(u32x4){PKW(pB0,8),PKW(pB0,10),PKW(pB0,12),PKW(pB0,14)};pw2=(u32x4){PKW(pB1,0),PKW(pB1,2),PKW(pB1,4),PKW(pB1,6)};pw3=(u32x4){PKW(pB1,8),PKW(pB1,10),PKW(pB1,12),PKW(pB1,14)};
    SBAR(); pv(o,vb0+2*sl_cur,PAF(0),PAF(1),PAF(2),PAF(3)); }
  #undef PKW
  #undef PAF
  #undef VFR
  #undef PIN
  #undef MX3
  #undef GAPA
  #undef GAPB
  #undef GW
  #undef SP
  #undef PAFX
  #undef EX
  #undef VRD
  #undef KRD
  #undef VRD2
  #undef STEP
  #undef ENDW
  {auto rr=__builtin_amdgcn_permlane32_swap(__float_as_uint(l_reg),__float_as_uint(l_reg),false,false);l_reg=__uint_as_float(rr[0])+__uint_as_float(rr[1]);}
  if(hie==0)wsf[32+r32e]=l_reg;asm volatile("s_waitcnt lgkmcnt(0)":::"memory");
  float rli[16];
  #pragma unroll
  for(int r=0;r<16;++r)rli[r]=__builtin_amdgcn_rcpf(wsf[32+crow(r,hie)]);
  { bf16*stg=(bf16*)(shm+LDS_OST)+wid*2048;
    #define BFLO(u) __uint_as_float((u)<<16)
    #define BFHI(u) __uint_as_float((u)&0xffff0000u)
    #pragma unroll
    for(int r=0;r<16;++r){const int orow=crow(r,hie);
      #pragma unroll
      for(int d0=0;d0<2;++d0)stg[orow*64+d0*32+r32e]=__float2bfloat16(o[d0][r]*rli[r]);}
    asm volatile("s_waitcnt lgkmcnt(0)":::"memory");
    if constexpr(!WIDE){
      #pragma unroll
      for(int i=0;i<4;++i){const int row=i*8+(le>>3),ch=le&7; const u32x4 v=*(const u32x4*)(stg+row*64+ch*8); const u32x4 zz=pz[i][0]; u32x4 y;
        #pragma unroll
        for(int e=0;e<4;++e) y[e]=cvtpk_s(BFLO(v[e])*BFLO(zz[e]),BFHI(v[e])*BFHI(zz[e]));
        ATTN_STORE16(EA.out+orow0+(long)row*1024+ch*8,y);}
    } else {
      u32x4 va[4];
      #pragma unroll
      for(int i=0;i<4;++i){const int row=i*8+(le>>3),ch=le&7; va[i]=*(const u32x4*)(stg+row*64+ch*8); if(EA.mode==1)ATTN_STORE16(EA.out+orow0+(long)row*1024+ch*8,va[i]);}
      asm volatile("s_waitcnt lgkmcnt(0)":::"memory");
      #pragma unroll
      for(int r=0;r<16;++r){const int orow=crow(r,hie);
        #pragma unroll
        for(int d0=0;d0<2;++d0)stg[orow*64+d0*32+r32e]=__float2bfloat16(o[2+d0][r]*rli[r]);}
      asm volatile("s_waitcnt lgkmcnt(0)":::"memory");
      if(EA.mode==1){
        #pragma unroll
        for(int i=0;i<4;++i){const int row=i*8+(le>>3),ch=le&7; const u32x4 v=*(const u32x4*)(stg+row*64+ch*8); ATTN_STORE16(EA.out+orow0+(long)row*1024+64+ch*8,v);}
      } else {
        float t1=EA.lq1[le]*EA.lk1[le],t2=EA.lq2[le]*EA.lk2[le];
        #pragma unroll
        for(int o_=1;o_<64;o_<<=1){t1+=__shfl_xor(t1,o_);t2+=__shfl_xor(t2,o_);}
        const float lam=__expf(t1)-__expf(t2)+0.2f;
        #pragma unroll
        for(int i=0;i<4;++i){const int row=i*8+(le>>3),ch=le&7; const u32x4 vb=*(const u32x4*)(stg+row*64+ch*8); const u32x4 v0=va[i];
          const u32x4 o00=po[i][0],o01=po[i][1]; const u32x4 za=pz[i][0],zb=pz[i][1];
          float a[8],b[8]; float ss=0.f;
          #pragma unroll
          for(int e=0;e<4;++e){ a[2*e]=BFLO(o00[e])-lam*BFLO(v0[e]); a[2*e+1]=BFHI(o00[e])-lam*BFHI(v0[e]); b[2*e]=BFLO(o01[e])-lam*BFLO(vb[e]); b[2*e+1]=BFHI(o01[e])-lam*BFHI(vb[e]); }
          #pragma unroll
          for(int e=0;e<8;++e) ss+=a[e]*a[e]+b[e]*b[e];
          ss+=__shfl_xor(ss,1); ss+=__shfl_xor(ss,2); ss+=__shfl_xor(ss,4);
          const float rs=__builtin_amdgcn_rsqf(ss*(1.f/128.f)+1e-6f)*0.8f;
          const f32x4_t ga0=*reinterpret_cast<const f32x4_t*>(EA.gsub+ch*8),ga1=*reinterpret_cast<const f32x4_t*>(EA.gsub+ch*8+4),gb0=*reinterpret_cast<const f32x4_t*>(EA.gsub+64+ch*8),gb1=*reinterpret_cast<const f32x4_t*>(EA.gsub+64+ch*8+4);
          u32x4 ya,yb;
          #pragma unroll
          for(int e=0;e<4;++e){ const float g0=(e<2)?ga0[2*e]:ga1[2*e-4], g1=(e<2)?ga0[2*e+1]:ga1[2*e-3], h0=(e<2)?gb0[2*e]:gb1[2*e-4], h1=(e<2)?gb0[2*e+1]:gb1[2*e-3];
            ya[e]=cvtpk_s(a[2*e]*rs*g0*BFLO(za[e]),a[2*e+1]*rs*g1*BFHI(za[e])); yb[e]=cvtpk_s(b[2*e]*rs*h0*BFLO(zb[e]),b[2*e+1]*rs*h1*BFHI(zb[e])); }
          ATTN_STORE16(EA.out+orow0+(long)row*1024+ch*8,ya); ATTN_STORE16(EA.out+orow0+(long)row*1024+64+ch*8,yb);}
      }
    }
    #undef BFLO
    #undef BFHI
  }
  asm volatile("s_waitcnt lgkmcnt(0)\n\ts_barrier":::"memory");
  #undef DMA_K
  #undef DMA_V
  #undef WB
  #undef CMASK
  #undef BMASK
  #undef START
  #undef RESC
  #undef ROT
}
constexpr int ATTN_LDS_BYTES=LDS_BYTES;
struct AttnArgs { const bf16* proj; const bf16* z; bf16* y; bf16* od; const float* kmean; const float* gsub; const float* lq1; const float* lk1; const float* lq2; const float* lk2; };
__device__ __forceinline__ void attn_geom(int i,int j,const bf16*base,const bf16*&q,const bf16*&k,const bf16*&vv,int&qb){
  const bool mb=i<8; const int d=i-8,h=d>>1,mp=d&1; qb=((mb?i:h)&1)?7-j:j;
  const int gq=mb?i:24+h*2+mp, gk=mb?8+i:32+h*2+mp, gv=mb?16+i:40+h*2;
  q=base+(long)gq*MROWS*64; k=base+(long)gk*MROWS*64; vv=base+(long)gv*MROWS*64;
}
template<int THRL=8> __device__ __forceinline__ void attn_phase(char*lds,const AttnArgs&T,int vcu,int G,const int wave_s){
  for(int v=vcu;v<256;v+=G){
    const int g=v>>3,j=v&7; const bf16*base=T.proj+(long)g*SEQ*PQ;
    const long rb=(long)g*SEQ*1024;
    bf16x8 qr[4]; const bf16*q,*k,*vv; int qb; attn_geom(0,j,base,q,k,vv,qb);
    attn_prefetch(q,k,qb,qr,lds,wave_s);
    for(int i=0;i<16;++i){ const bool mb=i<8; const int d=i-8,h=d>>1,mp=d&1;
      attn_geom(i,j,base,q,k,vv,qb);
      const bf16*qn,*kn,*vn; int qbn; attn_geom(i<15?i+1:15,j,base,qn,kn,vn,qbn);
      EpiArgs EA; EA.mode=mb?0:(mp?2:1);
      EA.out=mb?T.y+rb+i*64:(mp?T.y+rb+512+h*128:T.od+rb+h*256);
      EA.z=mb?T.z+rb+i*64:T.z+rb+512+h*128; EA.od=T.od+rb+h*256; EA.gsub=T.gsub; EA.lq1=T.lq1; EA.lk1=T.lk1; EA.lq2=T.lq2; EA.lk2=T.lk2;
      if(mb) attn_unit<THRL,false>(qb,qr,k,vv,EA,T.kmean+g*8192+(i&7)*64,true,qn,kn,qbn,lds,wave_s);
      else   attn_unit<THRL,true>(qb,qr,k,vv,EA,T.kmean,i<15,qn,kn,qbn,lds,wave_s); }
  }
}
#undef SBAR
#undef WAIT_BAR
}
constexpr int NWAVES = 8;
#ifndef MK_N_LAUNCHES
#define MK_N_LAUNCHES 1
#endif
constexpr int N_PHASES = 8;
constexpr int N_LAUNCHES = MK_N_LAUNCHES;
constexpr int BATCH = 32, SEQ = 2048, D = 1024, PLE = 256, PROJ = 4096;
constexpr int M = BATCH * SEQ;
constexpr float EPS = 1e-6f;
constexpr size_t MiB = 1u << 20;
constexpr size_t WS_WIN = 2 * MiB, WS_WOUT = 10 * MiB, WS_WG = 12 * MiB, WS_WPLE = 14 * MiB;
constexpr size_t WS_ROPE = 15 * MiB;
constexpr size_t WS_KMEAN = 16 * MiB;
constexpr size_t WS_CNT = 1 * MiB;
constexpr size_t WS_PART = 20 * MiB;
constexpr size_t WS_PART2 = 24 * MiB;
constexpr size_t WS_PROJ = 32 * MiB;
constexpr size_t WS_Z = 416 * MiB;
constexpr size_t WS_HB = 32 * MiB, WS_PE = 160 * MiB;
constexpr size_t WS_XN = 544 * MiB;
constexpr size_t WS_OM = 672 * MiB;
constexpr size_t WS_OD = 736 * MiB;
constexpr size_t WS_PB = 864 * MiB;
constexpr size_t WS_END = 896 * MiB;
constexpr int RING_OFF = 0, RING_BYTES = 131072;
constexpr int LDS_BYTES = 147456;

#define GAS __attribute__((address_space(1)))
#define LAS __attribute__((address_space(3)))
typedef unsigned short bf16;
typedef unsigned v4u __attribute__((ext_vector_type(4)));
typedef float f32x4 __attribute__((ext_vector_type(4)));
#define LDS_WAIT() asm volatile("s_waitcnt lgkmcnt(0)" ::: "memory")
__device__ __forceinline__ unsigned f2bf(float f) { unsigned u = __builtin_bit_cast(unsigned, f); return (u + 0x7fffu + ((u >> 16) & 1u)) >> 16; }
__device__ __forceinline__ unsigned pk2(float lo, float hi) { return f2bf(lo) | (f2bf(hi) << 16); }
__device__ __forceinline__ float bflo(unsigned u) { return __uint_as_float(u << 16); }
__device__ __forceinline__ float bfhi(unsigned u) { return __uint_as_float(u & 0xffff0000u); }

typedef GAS unsigned gu32;
#define RLX_AGENT __ATOMIC_RELAXED, __HIP_MEMORY_SCOPE_AGENT
#define XB_TMO      128
#define XB_XCNT(j)  (256  + 64 * (j))
#define XB_XSUB(j)  (1280 + 64 * (j))
#define XB_XGEN(j)  (2304 + 64 * (j))
#define XB_TOP      3328
#define XB_TOPGEN   3392
#define XCD_BAR_WORDS 3456
#define XB_SPIN_CAP (1u << 18)

__device__ __forceinline__ unsigned xb_ld(unsigned* p)              { return __hip_atomic_load(p, __ATOMIC_RELAXED, __HIP_MEMORY_SCOPE_AGENT); }
__device__ __forceinline__ unsigned xb_add(unsigned* p, unsigned v) { return __hip_atomic_fetch_add(p, v, __ATOMIC_RELAXED, __HIP_MEMORY_SCOPE_AGENT); }
__device__ __forceinline__ unsigned xb_xcc_id() { return (unsigned)__builtin_amdgcn_s_getreg((3 << 11) | 20) & 0xFu; }
#define XB_SPIN(cond, bar) do { unsigned _sp = 0; while (cond) { __builtin_amdgcn_s_sleep(1); \
    if ((++_sp & 255u) == 0u) { if (xb_ld(&(bar)[XB_TMO])) break; if (_sp > XB_SPIN_CAP) { atomicAdd(&(bar)[XB_TMO], 1u); break; } } } } while (0)

struct XcdBarrier {
    unsigned* bar; unsigned x;
    volatile LAS unsigned* st;
};

__device__ __forceinline__ XcdBarrier xcd_barrier_post(unsigned* bar, volatile LAS unsigned* st, const int tid_) {
    XcdBarrier b; b.bar = bar; b.x = xb_xcc_id(); b.st = st;
    if (tid_ == 0) (void)xb_add(&bar[XB_XCNT(b.x)], 1u);
    return b;
}
__device__ __forceinline__ void xcd_barrier_complete(unsigned* bar, unsigned x, unsigned& nloc, unsigned& nx) {
    const unsigned G = gridDim.x * gridDim.y * gridDim.z;
    unsigned sum, cnt, mine, sp = 0u;
    for (;;) {
        sum = 0u; cnt = 0u; mine = 0u;
#pragma unroll
        for (unsigned j = 0; j < 16; ++j) { const unsigned c = xb_ld(&bar[XB_XCNT(j)]); sum += c; cnt += (c > 0u) ? 1u : 0u; mine = (j == x) ? c : mine; }
        if (sum == G) break;
        __builtin_amdgcn_s_sleep(1);
        if ((++sp & 255u) == 0u) { if (xb_ld(&bar[XB_TMO])) break; if (sp > XB_SPIN_CAP) { atomicAdd(&bar[XB_TMO], 1u); break; } }
    }
    nloc = mine > 0u ? mine : 1u; nx = cnt > 0u ? cnt : 1u;
}

__device__ __forceinline__ void xcd_barrier(const XcdBarrier& b, const int tid_) {
    asm volatile("s_waitcnt vmcnt(0)" ::: "memory");
    __syncthreads();
    if (tid_ == 0) {
        unsigned* bar = b.bar;
        __builtin_amdgcn_s_waitcnt(0);
        unsigned nloc = b.st[0], nx = b.st[1];
        if (nloc == 0u) { xcd_barrier_complete(bar, b.x, nloc, nx); b.st[0] = nloc; b.st[1] = nx; }
        const unsigned old = xb_add(&bar[XB_XSUB(b.x)], 1u);
        const unsigned gen = old / nloc;
        if (old + 1u == (gen + 1u) * nloc) {
            __builtin_amdgcn_fence(__ATOMIC_RELEASE, "agent");
            asm volatile("s_waitcnt vmcnt(0)" ::: "memory");
            const unsigned og = xb_add(&bar[XB_TOP], 1u);
            const unsigned tg = og / nx;
            if (og + 1u == (tg + 1u) * nx) xb_add(&bar[XB_TOPGEN], 1u);
            else XB_SPIN(xb_ld(&bar[XB_TOPGEN]) == tg, bar);
            __builtin_amdgcn_fence(__ATOMIC_ACQUIRE, "agent");
            xb_add(&bar[XB_XGEN(b.x)], 1u);
            asm volatile("s_waitcnt vmcnt(0)" ::: "memory");
        } else {
            XB_SPIN(xb_ld(&bar[XB_XGEN(b.x)]) == gen, bar);
            __builtin_amdgcn_fence(__ATOMIC_ACQUIRE, "agent");
            asm volatile("s_waitcnt vmcnt(0)" ::: "memory");
        }
    }
    __syncthreads();
}

struct Frame {
    LAS unsigned char* lds;
    int tid, lane, wave, vcu, G;
    const float *x, *p, *w_in, *w_out, *g_mix, *lq1, *lk1, *lq2, *lk2, *g_subln, *w_ple, *w_gate, *g_ple, *g_final; float* out;
    bf16 *WinT, *WoutT, *WgT, *WpleT, *PROJB, *ZB, *HB, *PE, *XN, *OM, *OD, *PB;
    float *ROPE, *KMEAN, *PART, *PART2; unsigned* CNT;
};
__device__ __forceinline__ float wave_sum(float v) {
#pragma unroll
    for (int o = 1; o < 64; o <<= 1) v += __shfl_xor(v, o);
    return v;
}
__device__ __forceinline__ void p0_transpose_item(const float* W, int K, int N, bf16* WT, const float* kscale, LAS float* scr, int item, int lane, bool perm64 = false) {
    const int nblk = N / 32, kb = item / nblk, nb = item % nblk, k0 = 64 * kb, n0 = 32 * nb;
    const int n0w = perm64 ? (nb >> 3) * 256 + (nb & 1) * 128 + ((nb & 7) >> 1) * 32 : n0;
#pragma unroll 8
    for (int i = 0; i < 32; ++i) { const int kk = 2 * i + (lane >> 5); float w = W[(size_t)(k0 + kk) * N + n0 + (lane & 31)]; if (kscale) w *= kscale[k0 + kk]; scr[kk * 33 + (lane & 31)] = w; }
    LDS_WAIT(); asm volatile("" ::: "memory");
    const int c = lane & 7;
#pragma unroll
    for (int j = 0; j < 4; ++j) { const int n = (lane >> 3) + 8 * j; const LAS float* s = scr + (8 * c) * 33 + n;
        v4u o; o.x = pk2(s[0 * 33], s[1 * 33]); o.y = pk2(s[2 * 33], s[3 * 33]); o.z = pk2(s[4 * 33], s[5 * 33]); o.w = pk2(s[6 * 33], s[7 * 33]);
        *(GAS v4u*)(WT + (size_t)(n0w + n) * K + k0 + 8 * c) = o; }
    LDS_WAIT(); asm volatile("" ::: "memory");
}
__device__ __forceinline__ void p0_prologue(Frame& F) {
    LAS float* scr = (LAS float*)(F.lds + RING_OFF + F.wave * 16384);
    const int gw = F.vcu * NWAVES + F.wave, NGW = F.G * NWAVES;
    constexpr int I_IN = (D / 64) * (PROJ / 32), I_OUT = (D / 64) * (D / 32), I_G = I_OUT, I_PLE = (PLE / 64) * (D / 32);
    constexpr int NITEMS = I_IN + I_OUT + I_G + I_PLE;
    for (int it = gw; it < NITEMS; it += NGW) {
        int r = it;
        if (r < I_IN) { p0_transpose_item(F.w_in, D, PROJ, F.WinT, nullptr, scr, r, F.lane, true); continue; } r -= I_IN;
        if (r < I_OUT) { p0_transpose_item(F.w_out, D, D, F.WoutT, nullptr, scr, r, F.lane); continue; } r -= I_OUT;
        if (r < I_G) { p0_transpose_item(F.w_gate, D, D, F.WgT, F.g_ple, scr, r, F.lane); continue; } r -= I_G;
        p0_transpose_item(F.w_ple, PLE, D, F.WpleT, nullptr, scr, r, F.lane);
    }
    if (F.vcu == 0 && F.tid < 256) F.CNT[64 * F.tid] = 0u;
    { const int gt = F.vcu * (NWAVES * 64) + F.tid;
      if (gt < SEQ * 8) { const int pos = gt >> 3, j = gt & 7;
        const double inv = (j == 0) ? 0.15915494309189535 : (j == 1) ? 0.03086376340470123 : (j == 2) ? 0.005985185712713705 : (j == 3) ? 0.001160663641240061 : (j == 4) ? 0.00022507907903927653 : (j == 5) ? 4.364795279280289e-05 : (j == 6) ? 8.464330808241401e-06 : 1.6414262627950345e-06;
        double rev = (double)pos * inv; rev -= __builtin_rint(rev); const float rf = (float)rev;
        F.ROPE[pos * 16 + j] = __builtin_amdgcn_cosf(rf); F.ROPE[pos * 16 + 8 + j] = __builtin_amdgcn_sinf(rf); } }
    { f32x4 g[4];
#pragma unroll
      for (int j = 0; j < 4; ++j) g[j] = ((const GAS f32x4*)F.g_mix)[F.lane + 64 * j];
      for (int m0 = gw * 4; m0 < M; m0 += NGW * 4) {
        f32x4 v[4][4]; float s2[4];
#pragma unroll
        for (int r = 0; r < 4; ++r) { const GAS f32x4* xr = (const GAS f32x4*)(F.x + (size_t)(m0 + r) * D) + F.lane;
#pragma unroll
          for (int j = 0; j < 4; ++j) v[r][j] = __builtin_nontemporal_load(xr + 64 * j); }
#pragma unroll
        for (int r = 0; r < 4; ++r) { s2[r] = 0.f;
#pragma unroll
          for (int j = 0; j < 4; ++j) s2[r] += (v[r][j].x * v[r][j].x + v[r][j].y * v[r][j].y) + (v[r][j].z * v[r][j].z + v[r][j].w * v[r][j].w); }
#pragma unroll
        for (int o = 1; o < 64; o <<= 1) {
#pragma unroll
          for (int r = 0; r < 4; ++r) s2[r] += __shfl_xor(s2[r], o); }
#pragma unroll
        for (int r = 0; r < 4; ++r) { const float rs = 1.f / sqrtf(s2[r] * (1.f / D) + EPS);
          GAS unsigned long long* o8 = (GAS unsigned long long*)(F.XN + (size_t)(m0 + r) * D) + F.lane;
#pragma unroll
          for (int j = 0; j < 4; ++j) { const f32x4 w = v[r][j] * rs * g[j]; o8[64 * j] = (unsigned long long)pk2(w.x, w.y) | ((unsigned long long)pk2(w.z, w.w) << 32); } } } }
    { const size_t nthr = (size_t)F.G * NWAVES * 64; const size_t n8 = (size_t)M * PLE / 8;
      for (size_t i = (size_t)F.vcu * (NWAVES * 64) + F.tid; i < n8; i += nthr) { const f32x4 a = ((const GAS f32x4*)F.p)[2 * i], b = ((const GAS f32x4*)F.p)[2 * i + 1];
        v4u o; o.x = pk2(a.x, a.y); o.y = pk2(a.z, a.w); o.z = pk2(b.x, b.y); o.w = pk2(b.z, b.w); ((GAS v4u*)F.PB)[i] = o; } }
}
__device__ __forceinline__ void final_phase(Frame& F) {
    const int gw = F.vcu * NWAVES + F.wave, NGW = F.G * NWAVES;
    f32x4 g[4];
#pragma unroll
    for (int j = 0; j < 4; ++j) g[j] = ((const GAS f32x4*)F.g_final)[F.lane + 64 * j];
    for (int m0 = gw * 4; m0 < M; m0 += NGW * 4) {
        f32x4 v[4][4]; float s2[4];
#pragma unroll
        for (int r = 0; r < 4; ++r) { const GAS f32x4* xr = (const GAS f32x4*)(F.out + (size_t)(m0 + r) * D) + F.lane;
#pragma unroll
          for (int j = 0; j < 4; ++j) v[r][j] = xr[64 * j]; }
#pragma unroll
        for (int r = 0; r < 4; ++r) { s2[r] = 0.f;
#pragma unroll
          for (int j = 0; j < 4; ++j) s2[r] += (v[r][j].x * v[r][j].x + v[r][j].y * v[r][j].y) + (v[r][j].z * v[r][j].z + v[r][j].w * v[r][j].w); }
#pragma unroll
        for (int o = 1; o < 64; o <<= 1) {
#pragma unroll
          for (int r = 0; r < 4; ++r) s2[r] += __shfl_xor(s2[r], o); }
#pragma unroll
        for (int r = 0; r < 4; ++r) { const float rs = 1.f / sqrtf(s2[r] * (1.f / D) + EPS);
          GAS f32x4* xw = (GAS f32x4*)(F.out + (size_t)(m0 + r) * D) + F.lane;
#pragma unroll
          for (int j = 0; j < 4; ++j) __builtin_nontemporal_store(v[r][j] * rs * g[j], xw + 64 * j); }
    }
}

struct Args { const float* in[14]; float* out; unsigned char* ws; int ph_lo, ph_hi, cgsync, pad; };
__global__ void __launch_bounds__(NWAVES * 64, 2) mk_fwd(Args args) {
    extern __shared__ __attribute__((aligned(16))) unsigned char lds[];
    Frame F;
    F.lds = (LAS unsigned char*)lds;
    F.tid = threadIdx.x; F.lane = F.tid & 63; F.wave = __builtin_amdgcn_readfirstlane(F.tid >> 6);
    F.G = gridDim.x; { const int bx = blockIdx.x; F.vcu = (F.G % 8 == 0) ? (bx % 8) * (F.G / 8) + bx / 8 : bx; }
    unsigned char* ws = args.ws;
    F.x = args.in[0]; F.p = args.in[1]; F.w_in = args.in[2]; F.w_out = args.in[3]; F.g_mix = args.in[4]; F.lq1 = args.in[5]; F.lk1 = args.in[6]; F.lq2 = args.in[7]; F.lk2 = args.in[8];
    F.g_subln = args.in[9]; F.w_ple = args.in[10]; F.w_gate = args.in[11]; F.g_ple = args.in[12]; F.g_final = args.in[13]; F.out = args.out;
    F.WinT = (bf16*)(ws + WS_WIN); F.WoutT = (bf16*)(ws + WS_WOUT); F.WgT = (bf16*)(ws + WS_WG); F.WpleT = (bf16*)(ws + WS_WPLE);
    F.PROJB = (bf16*)(ws + WS_PROJ); F.ZB = (bf16*)(ws + WS_Z); F.HB = (bf16*)(ws + WS_HB); F.PE = (bf16*)(ws + WS_PE); F.XN = (bf16*)(ws + WS_XN); F.OM = (bf16*)(ws + WS_OM); F.OD = (bf16*)(ws + WS_OD); F.PB = (bf16*)(ws + WS_PB);
    F.ROPE = (float*)(ws + WS_ROPE); F.KMEAN = (float*)(ws + WS_KMEAN); F.PART = (float*)(ws + WS_PART); F.PART2 = (float*)(ws + WS_PART2); F.CNT = (unsigned*)(ws + WS_CNT);
    const int lo = args.ph_lo, hi = args.ph_hi;
    volatile LAS unsigned* MISC = (volatile LAS unsigned*)(F.lds + RING_BYTES + 320);
    if (F.tid < 32) MISC[F.tid] = 0u;
    __syncthreads();
    XcdBarrier bar = xcd_barrier_post((unsigned*)ws, MISC + 8, F.tid);
#ifndef REP_PHASE
#define REP_PHASE -1
#endif
#define NREP(k) (((k) == REP_PHASE) ? 2 : 1)
#ifndef PHMASK
#define PHMASK 0xff
#endif
#define IN(k) (((PHMASK >> (k)) & 1) && lo <= (k) && (k) < hi)
#define GRIDBAR() do { if (args.cgsync) cg::this_grid().sync(); else xcd_barrier(bar, tid_now(F.wave)); } while (0)
#define SEAM3B do { if (IN(3) && IN(5)) { GRIDBAR(); } } while (0)
#define SEAM(k) do { if (IN(k) && IN((k) + 1)) { GRIDBAR(); } } while (0)

    if (IN(0)) { for (int rp = 0; rp < NREP(0); ++rp) p0_prologue(F); }
    SEAM(0);
    if (IN(1)) {
        pg8::Gemm g{F.XN, F.WinT, M, PROJ, D}; pg8::StaticOrder S; S.init(M, PROJ, F.G, (int)blockIdx.x);
        pg8::EpiProj E{F.PROJB, F.ZB, F.ROPE, F.KMEAN};
        pg8::gemm_phase<pg8::EpiProj, pg8::StaticOrder, PG8_ALIGN, PG8_SP2>(F.lds + RING_OFF, g, S, E, F.wave);
    }
    if (IN(1) && NREP(1) == 2) {
        pg8::Gemm g{F.XN, F.WinT, M, PROJ, D}; pg8::StaticOrder S; S.init(M, PROJ, F.G, (int)blockIdx.x);
        pg8::EpiProj E{F.PROJB, F.ZB, F.ROPE, F.KMEAN};
        pg8::gemm_phase<pg8::EpiProj, pg8::StaticOrder, PG8_ALIGN, PG8_SP2>(F.lds + RING_OFF, g, S, E, F.wave);
    }
    if (IN(1) && IN(3)) { GRIDBAR(); }
    if (IN(3)) for (int rp = 0; rp < NREP(3); ++rp) {
        const attn_body::AttnArgs AT{(const attn_body::bf16*)F.PROJB, (const attn_body::bf16*)F.ZB, (attn_body::bf16*)F.XN, (attn_body::bf16*)F.OD, F.KMEAN, F.g_subln, F.lq1, F.lk1, F.lq2, F.lk2};
        attn_body::attn_phase<8>((char*)lds + RING_OFF, AT, F.vcu, F.G, F.wave);
    }
    SEAM3B;
    if (IN(5)) {
        { pg8::Gemm g{F.XN, F.WoutT, M, D, D}; pg8::StaticOrder S; S.init(M, D, F.G, (int)blockIdx.x);
          pg8::EpiOut E{F.x, F.HB, F.PART};
          pg8::gemm_phase<pg8::EpiOut, pg8::StaticOrder, PG8_ALIGN, PG8_SP2>(F.lds + RING_OFF, g, S, E, F.wave); }
        { int kple = PLE; asm volatile("" : "+s"(kple));
          pg8::Gemm g{F.PB, F.WpleT, M, D, kple}; pg8::StaticOrder S; S.init(M, D, F.G, (int)blockIdx.x);
          pg8::EpiBf16<0> E{F.PE, D, nullptr, 0, 0, 1.f};
          pg8::gemm_phase<pg8::EpiBf16<0>, pg8::StaticOrder, PG8_ALIGN, PG8_SP2>(F.lds + RING_OFF, g, S, E, F.wave); }
    }
    if (IN(5) && NREP(5) == 2) {
        { pg8::Gemm g{F.XN, F.WoutT, M, D, D}; pg8::StaticOrder S; S.init(M, D, F.G, (int)blockIdx.x);
          pg8::EpiOut E{F.x, F.HB, F.PART};
          pg8::gemm_phase<pg8::EpiOut, pg8::StaticOrder, PG8_ALIGN, PG8_SP2>(F.lds + RING_OFF, g, S, E, F.wave); }
        { int kple = PLE; asm volatile("" : "+s"(kple));
          pg8::Gemm g{F.PB, F.WpleT, M, D, kple}; pg8::StaticOrder S; S.init(M, D, F.G, (int)blockIdx.x);
          pg8::EpiBf16<0> E{F.PE, D, nullptr, 0, 0, 1.f};
          pg8::gemm_phase<pg8::EpiBf16<0>, pg8::StaticOrder, PG8_ALIGN, PG8_SP2>(F.lds + RING_OFF, g, S, E, F.wave); }
    }
    SEAM(5);
    if (IN(6)) {
        pg8::Gemm g{F.HB, F.WgT, M, D, D}; pg8::StaticOrder S; S.init(M, D, F.G, (int)blockIdx.x);
        pg8::EpiGate E{F.HB, F.PE, F.out, F.PART, F.PART2, F.CNT, F.g_final};
        pg8::gemm_phase<pg8::EpiGate, pg8::StaticOrder, PG8_ALIGN, PG8_SP2>(F.lds + RING_OFF, g, S, E, F.wave);
    }
#undef IN
#undef SEAM
}

extern "C" void kernel_launch(void* const* d_in, const int* in_sizes, int n_in, void* d_out, int out_size, void* d_ws, size_t ws_size, hipStream_t stream) {
    static int grid = 0;
    if (grid == 0) {
        if (n_in != 14 || in_sizes[0] != M * D || out_size != M * D || ws_size < WS_END) { fprintf(stderr, "kernel_launch: shape/workspace mismatch: n_in %d, in0 %d, out %d, ws %zu (need %zu)\n", n_in, n_in > 0 ? in_sizes[0] : -1, out_size, ws_size, (size_t)WS_END); grid = -1; return; }
        int dev = 0, cus = 0, per_cu = 0;
        if (hipGetDevice(&dev) != hipSuccess || hipDeviceGetAttribute(&cus, hipDeviceAttributeMultiprocessorCount, dev) != hipSuccess) { fprintf(stderr, "kernel_launch: device query failed\n"); grid = -1; return; }
        if (hipFuncSetAttribute((const void*)mk_fwd, hipFuncAttributeMaxDynamicSharedMemorySize, LDS_BYTES) != hipSuccess) { fprintf(stderr, "kernel_launch: hipFuncSetAttribute failed\n"); grid = -1; return; }
        if (hipOccupancyMaxActiveBlocksPerMultiprocessor(&per_cu, (const void*)mk_fwd, NWAVES * 64, LDS_BYTES) != hipSuccess || per_cu < 1) { fprintf(stderr, "kernel_launch: occupancy query reports %d\n", per_cu); per_cu = 1; }
        (void)hipGetLastError();
        grid = cus;
    }
    if (grid < 0) return;
    if (hipMemsetAsync(d_ws, 0, 65536, stream) != hipSuccess) { fprintf(stderr, "kernel_launch: hipMemsetAsync failed\n"); return; }
    Args a{};
    for (int i = 0; i < 14; ++i) a.in[i] = (const float*)d_in[i];
    a.out = (float*)d_out; a.ws = (unsigned char*)d_ws;
    if (N_LAUNCHES == 1) {
        a.ph_lo = 0; a.ph_hi = N_PHASES;
        void* kargs[] = {&a};
        const hipError_t le = hipLaunchCooperativeKernel((const void*)mk_fwd, dim3(grid), dim3(NWAVES * 64), kargs, LDS_BYTES, stream);
        if (le != hipSuccess) fprintf(stderr, "kernel_launch: cooperative launch failed: %s (grid %d)\n", hipGetErrorString(le), grid);
    } else {
        for (int li = 0; li < N_PHASES; ++li) {
            a.ph_lo = li; a.ph_hi = li + 1;
            hipLaunchKernelGGL(mk_fwd, dim3(grid), dim3(NWAVES * 64), LDS_BYTES, stream, a);
            const hipError_t le = hipPeekAtLastError();
            if (le != hipSuccess) { fprintf(stderr, "kernel_launch: launch %d failed: %s\n", li, hipGetErrorName(le)); break; }
        }
    }
}
```

```cpp
#include <hip/hip_runtime.h>
#include <hip/hip_cooperative_groups.h>
#include <cstdio>
#include <cstdint>
namespace cg = cooperative_groups;
__device__ __forceinline__ int tid_now(int wave_s) { unsigned z = 0u; asm volatile("" : "+s"(z)); return wave_s * 64 + (int)__builtin_amdgcn_mbcnt_hi(~0u, __builtin_amdgcn_mbcnt_lo(~0u, z)); }
namespace pg8 {
#define PG8_LAS __attribute__((address_space(3)))
typedef unsigned short bf16_t;
typedef short bf16x8 __attribute__((ext_vector_type(8)));
typedef float f32x4 __attribute__((ext_vector_type(4)));
typedef unsigned u32x4 __attribute__((ext_vector_type(4)));
constexpr int BM = 256, BK = 64, HALF = 128, HTB = HALF * BK * 2  , STAGE_BYTES = 8 * HTB, NXCD = 8, WGM = 8;

__host__ __device__ __forceinline__ int lds_byte(int r, int c) { const int st = (r >> 4) * 2 + (c >> 5), rr = r & 15, cc = c & 31, ob = rr * 64 + cc * 2; return st * 1024 + (ob ^ (((ob >> 9) & 1) << 5)); }
__host__ __device__ __forceinline__ void stage_rc(int b, int& R, int& C) { const int st = b / 1024, sb = b % 1024, swz = sb ^ (((sb >> 9) & 1) << 5); R = (st >> 1) * 16 + swz / 64; C = (st & 1) * 32 + (swz % 64) / 2; }
__host__ __device__ __forceinline__ int perm32(int rho) { const int n = rho >> 4, i = rho & 15; return 8 * (i >> 2) + 4 * n + (i & 3); }

struct Unit { int pm, pn; };
struct Gemm { const bf16_t* A; const bf16_t* Bt; int M, N, K; };

struct StaticOrder {
    int nM, nN, nwg, G, c;
    __host__ __device__ void init(int M, int N, int G_, int c_) { nM = M / BM; nN = N / BM; nwg = nM * nN; G = G_; c = c_; }
    __host__ __device__ bool next(int i, Unit& u) const {
        const long L = (long)i * G + c; if (L >= nwg) return false;
        int wgid = (int)L; { const int q = nwg / NXCD, r = nwg % NXCD, xcd = wgid % NXCD, off = wgid / NXCD; wgid = (xcd < r ? xcd * (q + 1) : r * (q + 1) + (xcd - r) * q) + off; }
        const int nig = WGM * nN, gid = wgid / nig, fm = gid * WGM, gsz = (nM - fm) < WGM ? (nM - fm) : WGM;
        u.pm = fm + ((wgid % nig) % gsz); u.pn = (wgid % nig) / gsz; return true;
    }
    __device__ __forceinline__ void a_ready(const Unit&) const {}
    __device__ __forceinline__ void done(const Unit&) const {}
};

__device__ __forceinline__ unsigned cvt_pk_bf16(float lo, float hi) { unsigned r; asm volatile("v_cvt_pk_bf16_f32 %0, %1, %2" : "=v"(r) : "v"(lo), "v"(hi)); return r; }
typedef float f32x2 __attribute__((ext_vector_type(2)));
__device__ __forceinline__ f32x2 gelu_pk(f32x2 v) {
    const f32x2 av = __builtin_elementwise_abs(v), d = av * 0.2316418882f + 1.0f;
    f32x2 t; t.x = __builtin_amdgcn_rcpf(d.x); t.y = __builtin_amdgcn_rcpf(d.y);
    f32x2 q = t * 0.5307027145f + (-0.7265760135f); q = q * t + 0.7107068705f; q = q * t + (-0.142248368f); q = q * t + 0.127414796f; q = q * t;
    const f32x2 s = (v * v) * (-0.72134752044f);
    f32x2 e; e.x = __builtin_amdgcn_exp2f(s.x); e.y = __builtin_amdgcn_exp2f(s.y);
    const f32x2 m = v * (q * e), r = v - m;
    f32x2 o; o.x = v.x < 0.f ? m.x : r.x; o.y = v.y < 0.f ? m.y : r.y; return o;
}

template <int ACT  > struct EpiBf16 {
    static constexpr bool PERM = true, AFTER_DRAIN = false; static_assert(ACT == 0 || ACT == 1, "EpiBf16: ACT is 0 (none) or 1 (gelu_pk)");
    bf16_t* O; int ldc; const float* bias; int split_cols; size_t split_stride; float scale0;
    __device__ __forceinline__ void operator()(const f32x4 (&acc)[2][2][4][2], const Unit& u, int wr, int wc, int fr, int fq) const {
        const int row0 = u.pm * BM + wr * 64 + fr; int colt = u.pn * BM; bf16_t* base = O;
        float sc = 1.f; if (split_cols) { const int t = colt / split_cols; base += (size_t)t * split_stride; colt -= t * split_cols; if (t == 0) sc = scale0; }
        const int col0 = colt + wc * 32 + 8 * fq, bcol0 = u.pn * BM + wc * 32 + 8 * fq;
        f32x4 bv[2][2];
#pragma unroll
        for (int bj = 0; bj < 2; ++bj)
#pragma unroll
            for (int n = 0; n < 2; ++n) bv[bj][n] = bias ? *(const f32x4*)(bias + bcol0 + bj * HALF + 4 * n) : (f32x4){0.f, 0.f, 0.f, 0.f};
#pragma unroll
        for (int ai = 0; ai < 2; ++ai)
#pragma unroll
            for (int m = 0; m < 4; ++m) { bf16_t* rowp = base + (size_t)(row0 + ai * HALF + m * 16) * ldc + col0;
#pragma unroll
                for (int bj = 0; bj < 2; ++bj) { f32x4 v0 = acc[ai][bj][m][0] + bv[bj][0], v1 = acc[ai][bj][m][1] + bv[bj][1];
                    if (ACT == 1) { f32x2 a = gelu_pk((f32x2){v0[0], v0[1]}), b = gelu_pk((f32x2){v0[2], v0[3]}), c = gelu_pk((f32x2){v1[0], v1[1]}), d = gelu_pk((f32x2){v1[2], v1[3]});
                        v0 = (f32x4){a.x, a.y, b.x, b.y}; v1 = (f32x4){c.x, c.y, d.x, d.y}; }
                    v0 = v0 * sc; v1 = v1 * sc; u32x4 w; w.x = cvt_pk_bf16(v0[0], v0[1]); w.y = cvt_pk_bf16(v0[2], v0[3]); w.z = cvt_pk_bf16(v1[0], v1[1]); w.w = cvt_pk_bf16(v1[2], v1[3]);
                    *(u32x4*)(rowp + bj * HALF) = w; } }
    }
};
constexpr float QC2 = 0.125f * 1.4426950408889634f;
struct EpiProj {
    static constexpr bool PERM = true, AFTER_DRAIN = false;
    bf16_t* O; bf16_t* Z; const float* rope; float* kpart;
    __device__ __forceinline__ void operator()(const f32x4 (&acc)[2][2][4][2], const Unit& u, int wr, int wc, int fr, int fq) const {
        const int pn = u.pn;
        const bool do_rope = (pn < 4) || (pn >= 6 && pn < 10);
        const bool is_q = (pn < 2) || (pn == 6) || (pn == 7);
        const bool do_silu = pn >= 12;
        const float sc = is_q ? QC2 : 1.f;
        const int row0 = u.pm * BM + wr * 64 + fr;
        const float sg = (fq == 0) ? -1.f : 1.f;
        const bool is_mk = (pn == 2) || (pn == 3);
        f32x4 cs0 = {0.f, 0.f, 0.f, 0.f}, cs1 = cs0, cs2 = cs0, cs3 = cs0;
#pragma unroll
        for (int ai = 0; ai < 2; ++ai)
#pragma unroll
            for (int m = 0; m < 4; ++m) {
                const int row = row0 + ai * HALF + m * 16;
                bf16_t* rowp = do_silu ? Z + (size_t)row * 1024 + (pn - 12) * 256 + wc * 64 + 8 * fq : O + ((size_t)(pn * 4 + wc) * 65536 + row) * 64 + 8 * fq;
                f32x4 v0 = acc[ai][0][m][0], v1 = acc[ai][0][m][1], w0 = acc[ai][1][m][0], w1 = acc[ai][1][m][1];
                if (do_rope) {
                    f32x4 c0 = {1.f, 1.f, 1.f, 1.f}, c1 = c0, s0 = {0.f, 0.f, 0.f, 0.f}, s1 = s0;
                    if (fq < 2) { const float* rp = rope + (row & 2047) * 16; c0 = *(const f32x4*)(rp); c1 = *(const f32x4*)(rp + 4); s0 = *(const f32x4*)(rp + 8) * sg; s1 = *(const f32x4*)(rp + 12) * sg; }
                    f32x4 p0, p1;
#pragma unroll
                    for (int e = 0; e < 4; ++e) { p0[e] = __shfl_xor(v0[e], 16); p1[e] = __shfl_xor(v1[e], 16); }
                    v0 = v0 * c0 + p0 * s0; v1 = v1 * c1 + p1 * s1;
                }
                if (do_silu) {
#pragma unroll
                    for (int e = 0; e < 4; ++e) { v0[e] = v0[e] * __builtin_amdgcn_rcpf(1.f + __expf(-v0[e])); v1[e] = v1[e] * __builtin_amdgcn_rcpf(1.f + __expf(-v1[e]));
                                                  w0[e] = w0[e] * __builtin_amdgcn_rcpf(1.f + __expf(-w0[e])); w1[e] = w1[e] * __builtin_amdgcn_rcpf(1.f + __expf(-w1[e])); }
                }
                if (is_mk) { cs0 += v0; cs1 += v1; cs2 += w0; cs3 += w1; }
                v0 = v0 * sc; v1 = v1 * sc; w0 = w0 * sc; w1 = w1 * sc;
                u32x4 a, b; a.x = cvt_pk_bf16(v0[0], v0[1]); a.y = cvt_pk_bf16(v0[2], v0[3]); a.z = cvt_pk_bf16(v1[0], v1[1]); a.w = cvt_pk_bf16(v1[2], v1[3]);
                b.x = cvt_pk_bf16(w0[0], w0[1]); b.y = cvt_pk_bf16(w0[2], w0[3]); b.z = cvt_pk_bf16(w1[0], w1[1]); b.w = cvt_pk_bf16(w1[2], w1[3]);
                __builtin_nontemporal_store(a, (u32x4*)(rowp)); __builtin_nontemporal_store(b, (u32x4*)(rowp + 32));
            }
        if (is_mk) {
#pragma unroll
            for (int e = 0; e < 4; ++e) {
#pragma unroll
                for (int o = 1; o < 16; o <<= 1) { cs0[e] += __shfl_xor(cs0[e], o); cs1[e] += __shfl_xor(cs1[e], o); cs2[e] += __shfl_xor(cs2[e], o); cs3[e] += __shfl_xor(cs3[e], o); } }
            if (fr == 0) { float* kp = kpart + ((size_t)u.pm * 2 + wr) * 512 + (pn - 2) * 256 + wc * 64 + 8 * fq;
                *(f32x4*)(kp) = cs0; *(f32x4*)(kp + 4) = cs1; *(f32x4*)(kp + 32) = cs2; *(f32x4*)(kp + 36) = cs3; }
        }
    }
};
typedef unsigned u32x2 __attribute__((ext_vector_type(2)));
struct EpiOut {
    static constexpr bool PERM = false, AFTER_DRAIN = false;
    const float* x; bf16_t* hb; float* part;
    __device__ __forceinline__ void operator()(const f32x4 (&acc)[2][2][4][2], const Unit& u, int wr, int wc, int fr, int fq) const {
        const int col0 = u.pn * BM + wc * 32 + 4 * fq;
#pragma unroll
        for (int ai = 0; ai < 2; ++ai) {
            f32x4 xv[4][2][2];
#pragma unroll
            for (int m = 0; m < 4; ++m) { const size_t off = (size_t)(u.pm * BM + ai * HALF + wr * 64 + m * 16 + fr) * 1024 + col0;
#pragma unroll
                for (int bj = 0; bj < 2; ++bj)
#pragma unroll
                    for (int n = 0; n < 2; ++n) xv[m][bj][n] = __builtin_nontemporal_load((const f32x4*)(x + off + bj * HALF + n * 16)); }
#pragma unroll
            for (int m = 0; m < 4; ++m) {
                const int r = u.pm * BM + ai * HALF + wr * 64 + m * 16 + fr; const size_t off = (size_t)r * 1024 + col0; float ss = 0.f;
#pragma unroll
                for (int bj = 0; bj < 2; ++bj)
#pragma unroll
                    for (int n = 0; n < 2; ++n) {
                        const f32x4 h = xv[m][bj][n] + acc[ai][bj][m][n];
                        ss += (h[0] * h[0] + h[1] * h[1]) + (h[2] * h[2] + h[3] * h[3]);
                        u32x2 w; w.x = cvt_pk_bf16(h[0], h[1]); w.y = cvt_pk_bf16(h[2], h[3]);
                        *(u32x2*)(hb + off + bj * HALF + n * 16) = w;
                    }
                ss += __shfl_xor(ss, 16); ss += __shfl_xor(ss, 32);
                if (fq == 0) part[(size_t)r * 16 + u.pn * 4 + wc] = ss;
            }
            asm volatile("" ::: "memory");
        }
    }
};
struct EpiGate {
    static constexpr bool PERM = false, AFTER_DRAIN = false;
    const bf16_t* hb; const bf16_t* pe; float* out; const float* part; float* part2; unsigned* cnt; const float* gfin;
    __device__ __forceinline__ void operator()(f32x4 (&acc)[2][2][4][2], const Unit& u, int wr, int wc, int fr, int fq) const {
        const int col0 = u.pn * BM + wc * 32 + 4 * fq;
        const int rbase = u.pm * BM + wr * 64 + fr;
        float rs[8];
        { f32x4 q[8];
#pragma unroll
          for (int k = 0; k < 8; ++k) q[k] = *(const f32x4*)(part + (size_t)(rbase + (k >> 2) * HALF + (k & 3) * 16) * 16 + 4 * fq);
#pragma unroll
          for (int k = 0; k < 8; ++k) { float t = (q[k][0] + q[k][1]) + (q[k][2] + q[k][3]); t += __shfl_xor(t, 16); t += __shfl_xor(t, 32); rs[k] = __builtin_amdgcn_rsqf(t * (1.f / 1024.f) + 1e-6f); } }
#pragma unroll
        for (int kp = 0; kp < 4; ++kp) { const int ai = kp >> 1;
            u32x2 hv[2][2][2], pv[2][2][2];
#pragma unroll
            for (int mm = 0; mm < 2; ++mm) { const int m = (kp & 1) * 2 + mm; const size_t off = (size_t)(rbase + ai * HALF + m * 16) * 1024 + col0;
#pragma unroll
                for (int bj = 0; bj < 2; ++bj)
#pragma unroll
                    for (int n = 0; n < 2; ++n) { hv[mm][bj][n] = *(const u32x2*)(hb + off + bj * HALF + n * 16); pv[mm][bj][n] = *(const u32x2*)(pe + off + bj * HALF + n * 16); } }
#pragma unroll
            for (int mm = 0; mm < 2; ++mm) { const int m = (kp & 1) * 2 + mm;
#pragma unroll
                for (int bj = 0; bj < 2; ++bj)
#pragma unroll
                    for (int n = 0; n < 2; ++n) {
                        const u32x2 hw = hv[mm][bj][n], pw = pv[mm][bj][n];
                        const f32x4 h = {__uint_as_float(hw.x << 16), __uint_as_float(hw.x & 0xffff0000u), __uint_as_float(hw.y << 16), __uint_as_float(hw.y & 0xffff0000u)};
                        const f32x4 p = {__uint_as_float(pw.x << 16), __uint_as_float(pw.x & 0xffff0000u), __uint_as_float(pw.y << 16), __uint_as_float(pw.y & 0xffff0000u)};
                        const f32x4 a = acc[ai][bj][m][n] * rs[ai * 4 + m]; f32x4 o;
#pragma unroll
                        for (int e = 0; e < 4; ++e) o[e] = h[e] + p[e] * __builtin_amdgcn_rcpf(1.f + __expf(-a[e]));
                        acc[ai][bj][m][n] = o;
                    } }
            asm volatile("" ::: "memory");
        }
        { float ssv[8];
#pragma unroll
          for (int k = 0; k < 8; ++k) { const int ai = k >> 2, m = k & 3; float ss = 0.f;
#pragma unroll
            for (int bj = 0; bj < 2; ++bj)
#pragma unroll
                for (int n = 0; n < 2; ++n) { const f32x4 h = acc[ai][bj][m][n]; ss += (h[0] * h[0] + h[1] * h[1]) + (h[2] * h[2] + h[3] * h[3]); }
            ss += __shfl_xor(ss, 16); ss += __shfl_xor(ss, 32); ssv[k] = ss; }
          if (fq == 0) {
#pragma unroll
            for (int k = 0; k < 8; ++k) __hip_atomic_store(part2 + (size_t)(rbase + (k >> 2) * HALF + (k & 3) * 16) * 16 + u.pn * 4 + wc, ssv[k], __ATOMIC_RELAXED, __HIP_MEMORY_SCOPE_AGENT); } }
        asm volatile("s_waitcnt vmcnt(0)" ::: "memory");
        unsigned* c = cnt + 64 * u.pm;
        if (fr == 0 && fq == 0) __hip_atomic_fetch_add(c, 1u, __ATOMIC_RELAXED, __HIP_MEMORY_SCOPE_AGENT);
        { unsigned sp = 0;
          while ((unsigned)__builtin_amdgcn_readfirstlane(__hip_atomic_load(c, __ATOMIC_RELAXED, __HIP_MEMORY_SCOPE_AGENT)) < 32u) { __builtin_amdgcn_s_sleep(8); if (++sp > (1u << 20)) break; } }
#pragma unroll
        for (int k = 0; k < 8; ++k) { const float* pp = part2 + (size_t)(rbase + (k >> 2) * HALF + (k & 3) * 16) * 16 + 4 * fq;
            const float t0 = __hip_atomic_load(pp, __ATOMIC_RELAXED, __HIP_MEMORY_SCOPE_AGENT), t1 = __hip_atomic_load(pp + 1, __ATOMIC_RELAXED, __HIP_MEMORY_SCOPE_AGENT),
                        t2 = __hip_atomic_load(pp + 2, __ATOMIC_RELAXED, __HIP_MEMORY_SCOPE_AGENT), t3 = __hip_atomic_load(pp + 3, __ATOMIC_RELAXED, __HIP_MEMORY_SCOPE_AGENT);
            float t = (t0 + t1) + (t2 + t3); t += __shfl_xor(t, 16); t += __shfl_xor(t, 32); rs[k] = __builtin_amdgcn_rsqf(t * (1.f / 1024.f) + 1e-6f); }
        f32x4 gf[2][2];
#pragma unroll
        for (int bj = 0; bj < 2; ++bj)
#pragma unroll
            for (int n = 0; n < 2; ++n) gf[bj][n] = *(const f32x4*)(gfin + col0 + bj * HALF + n * 16);
#pragma unroll
        for (int k = 0; k < 8; ++k) { const int ai = k >> 2, m = k & 3; const size_t off = (size_t)(rbase + ai * HALF + m * 16) * 1024 + col0;
#pragma unroll
            for (int bj = 0; bj < 2; ++bj)
#pragma unroll
                for (int n = 0; n < 2; ++n) __builtin_nontemporal_store(acc[ai][bj][m][n] * rs[k] * gf[bj][n], (f32x4*)(out + off + bj * HALF + n * 16)); }
    }
};

template <class Epi, class Sched, bool ALIGN_EPI = false, bool SP2 = false>
__device__ __forceinline__ void gemm_phase(PG8_LAS unsigned char* lds, const Gemm g, const Sched& S, const Epi& E, const int wave_s) {
    const int tid = tid_now(wave_s), wid = __builtin_amdgcn_readfirstlane(tid >> 6), lane = tid & 63, wr = wid >> 2, wc = wid & 3, fr = lane & 15, fq = lane >> 4;
    const int K = g.K, nt = K / BK;
    unsigned voffA[2], voffB[2];
#pragma unroll
    for (int i = 0; i < 2; ++i) { int R, C; stage_rc(tid * 16 + i * 8192, R, C); const int Rb = Epi::PERM ? ((R & ~31) + perm32(R & 31)) : R;
        voffA[i] = (unsigned)(R * K + C) * 2u; voffB[i] = (unsigned)(Rb * K + C) * 2u; }
    const size_t kstep = (size_t)(BK * 2);
    const size_t hstep = (size_t)HALF * K * 2;
    const size_t tstep = 2 * hstep;
    const unsigned ldsw = (unsigned)wid * 1024u;
    const int aoff = lds_byte(wr * 64 + fr, fq * 8), boff = lds_byte(wc * 32 + fr, fq * 8);
#define PG8_SA(b, h) (((b) * 2 + (h)) * HTB)
#define PG8_SB(b, h) ((4 + (b) * 2 + (h)) * HTB)
#define PG8_STAGE(bufoff, gbase, voff) do { _Pragma("unroll") for (int _i = 0; _i < 2; ++_i) \
        __builtin_amdgcn_global_load_lds((const unsigned*)((const char*)(gbase) + (voff)[_i]), (PG8_LAS unsigned*)(lds + (bufoff) + ldsw + _i * 8192), 16, 0, 0); } while (0)
#define PG8_LDA(dst, b, h) do { _Pragma("unroll") for (int m = 0; m < 4; ++m) _Pragma("unroll") for (int k = 0; k < 2; ++k) dst[m][k] = *(const PG8_LAS bf16x8*)(lds + PG8_SA(b, h) + aoff + m * 2048 + k * 1024); } while (0)
#define PG8_LDB(dst, b, h) do { _Pragma("unroll") for (int n = 0; n < 2; ++n) _Pragma("unroll") for (int k = 0; k < 2; ++k) dst[n][k] = *(const PG8_LAS bf16x8*)(lds + PG8_SB(b, h) + boff + n * 2048 + k * 1024); } while (0)
#define PG8_MMA(ai, bj, At, Bt) do { __builtin_amdgcn_s_setprio(1); _Pragma("unroll") for (int m = 0; m < 4; ++m) _Pragma("unroll") for (int n = 0; n < 2; ++n) _Pragma("unroll") for (int k = 0; k < 2; ++k) \
        acc[ai][bj][m][n] = __builtin_amdgcn_mfma_f32_16x16x32_bf16(Bt[n][k], At[m][k], acc[ai][bj][m][n], 0, 0, 0); __builtin_amdgcn_s_setprio(0); } while (0)
#define PG8_WAIT_V(n) asm volatile("s_waitcnt vmcnt(" #n ")" ::: "memory")
#define PG8_WAIT_L(n) asm volatile("s_waitcnt lgkmcnt(" #n ")" ::: "memory")
#define PG8_BAR __builtin_amdgcn_s_barrier()
#define PG8_SCHED __builtin_amdgcn_sched_barrier(0)
    Unit cur, nxt; int ui = 0;
    if (!S.next(0, cur)) return;
    f32x4 acc[2][2][4][2];
#pragma unroll
    for (int a = 0; a < 2; ++a)
#pragma unroll
        for (int b = 0; b < 2; ++b)
#pragma unroll
            for (int m = 0; m < 4; ++m)
#pragma unroll
                for (int n = 0; n < 2; ++n) acc[a][b][m][n] = (f32x4){0.f, 0.f, 0.f, 0.f};
    bf16x8 At[4][2], B0[2][2], B1[2][2];
    const char* cA = (const char*)g.A + (size_t)cur.pm * tstep; const char* cB = (const char*)g.Bt + (size_t)cur.pn * tstep;
    S.a_ready(cur);
    if constexpr (SP2) {
        PG8_STAGE(PG8_SB(0, 0), cB, voffB); PG8_STAGE(PG8_SB(0, 1), cB + hstep, voffB); PG8_STAGE(PG8_SA(0, 0), cA, voffA); PG8_STAGE(PG8_SA(0, 1), cA + hstep, voffA);
        if (wr == 1) PG8_BAR;
        PG8_WAIT_V(2); PG8_BAR;
        PG8_STAGE(PG8_SB(1, 0), cB + kstep, voffB); PG8_STAGE(PG8_SA(1, 0), cA + kstep, voffA); PG8_STAGE(PG8_SB(1, 1), cB + hstep + kstep, voffB);
        PG8_WAIT_V(6); PG8_BAR;
    } else {
        PG8_STAGE(PG8_SB(0, 0), cB, voffB); PG8_STAGE(PG8_SA(0, 0), cA, voffA); PG8_STAGE(PG8_SB(0, 1), cB + hstep, voffB); PG8_STAGE(PG8_SA(0, 1), cA + hstep, voffA);
        if (wr == 1) PG8_BAR;
        PG8_WAIT_V(4); PG8_BAR;
        PG8_STAGE(PG8_SB(1, 0), cB + kstep, voffB); PG8_STAGE(PG8_SA(1, 0), cA + kstep, voffA); PG8_STAGE(PG8_SB(1, 1), cB + hstep + kstep, voffB);
        PG8_WAIT_V(6); PG8_BAR;
    }
    for (;;) {
        const bool has_next = S.next(ui + 1, nxt);
        const char* nA = has_next ? (const char*)g.A + (size_t)nxt.pm * tstep : cA; const char* nB = has_next ? (const char*)g.Bt + (size_t)nxt.pn * tstep : cB;
        for (int t = 0; t < nt; t += 2) {
            const bool last = (t == nt - 2);
            const char* a1 = cA + (size_t)(t + 1) * kstep;
            const char* a2 = last ? nA : cA + (size_t)(t + 2) * kstep; const char* b2 = last ? nB : cB + (size_t)(t + 2) * kstep;
            const char* a3 = a2 + kstep; const char* b3 = b2 + kstep;
            if (last && has_next) S.a_ready(nxt);
            if constexpr (SP2) {
            PG8_LDB(B0, 0, 0); PG8_LDB(B1, 0, 1); PG8_SCHED; PG8_LDA(At, 0, 0); PG8_STAGE(PG8_SA(1, 1), a1 + hstep, voffA);
            PG8_WAIT_V(8); PG8_WAIT_L(0); PG8_BAR; PG8_MMA(0, 0, At, B0); PG8_MMA(0, 1, At, B1); PG8_BAR; PG8_SCHED;
            PG8_LDA(At, 0, 1); PG8_STAGE(PG8_SB(0, 0), b2, voffB); PG8_STAGE(PG8_SB(0, 1), b2 + hstep, voffB); PG8_STAGE(PG8_SA(0, 0), a2, voffA);
            PG8_WAIT_V(8); PG8_WAIT_L(0); PG8_BAR; PG8_MMA(1, 0, At, B0); PG8_MMA(1, 1, At, B1); PG8_BAR; PG8_SCHED;
            PG8_LDB(B0, 1, 0); PG8_LDB(B1, 1, 1); PG8_SCHED; PG8_LDA(At, 1, 0); PG8_STAGE(PG8_SA(0, 1), a2 + hstep, voffA);
            PG8_WAIT_V(8); PG8_WAIT_L(0); PG8_BAR; PG8_MMA(0, 0, At, B0); PG8_MMA(0, 1, At, B1); PG8_BAR; PG8_SCHED;
            PG8_LDA(At, 1, 1); PG8_STAGE(PG8_SB(1, 0), b3, voffB); PG8_STAGE(PG8_SB(1, 1), b3 + hstep, voffB); PG8_STAGE(PG8_SA(1, 0), a3, voffA);
            PG8_WAIT_V(8); PG8_WAIT_L(0); PG8_BAR; PG8_MMA(1, 0, At, B0); PG8_MMA(1, 1, At, B1); PG8_BAR; PG8_SCHED;
            } else {
            PG8_LDB(B0, 0, 0); PG8_SCHED; PG8_LDA(At, 0, 0); PG8_STAGE(PG8_SA(1, 1), a1 + hstep, voffA);
            PG8_WAIT_L(8); PG8_BAR; PG8_WAIT_L(0); PG8_MMA(0, 0, At, B0); PG8_BAR; PG8_SCHED;
            PG8_LDB(B1, 0, 1); PG8_STAGE(PG8_SB(0, 0), b2, voffB);
            PG8_BAR; PG8_WAIT_L(0); PG8_MMA(0, 1, At, B1); PG8_BAR;
            PG8_LDA(At, 0, 1); PG8_STAGE(PG8_SA(0, 0), a2, voffA);
            PG8_BAR; PG8_WAIT_L(0); PG8_MMA(1, 0, At, B0); PG8_BAR; PG8_SCHED;
            PG8_STAGE(PG8_SB(0, 1), b2 + hstep, voffB);
            PG8_WAIT_V(6); PG8_BAR; PG8_MMA(1, 1, At, B1); PG8_BAR;
            PG8_LDB(B0, 1, 0); PG8_SCHED; PG8_LDA(At, 1, 0); PG8_STAGE(PG8_SA(0, 1), a2 + hstep, voffA);
            PG8_WAIT_L(8); PG8_BAR; PG8_WAIT_L(0); PG8_MMA(0, 0, At, B0); PG8_BAR; PG8_SCHED;
            PG8_LDB(B1, 1, 1); PG8_STAGE(PG8_SB(1, 0), b3, voffB);
            PG8_BAR; PG8_WAIT_L(0); PG8_MMA(0, 1, At, B1); PG8_BAR;
            PG8_LDA(At, 1, 1); PG8_STAGE(PG8_SA(1, 0), a3, voffA);
            PG8_BAR; PG8_WAIT_L(0); PG8_MMA(1, 0, At, B0); PG8_BAR; PG8_SCHED;
            PG8_STAGE(PG8_SB(1, 1), b3 + hstep, voffB);
            PG8_WAIT_V(6); PG8_BAR; PG8_MMA(1, 1, At, B1); PG8_BAR;
            }
        }
        if constexpr (ALIGN_EPI) { if (wr == 0) PG8_BAR; }
        if constexpr (!Epi::AFTER_DRAIN) { E(acc, cur, wr, wc, fr, fq); S.done(cur); }
        if (!has_next) break;
#pragma unroll
        for (int a = 0; a < 2; ++a)
#pragma unroll
            for (int b = 0; b < 2; ++b)
#pragma unroll
                for (int m = 0; m < 4; ++m)
#pragma unroll
                    for (int n = 0; n < 2; ++n) acc[a][b][m][n] = (f32x4){0.f, 0.f, 0.f, 0.f};
        cur = nxt; cA = nA; cB = nB; ++ui;
        if constexpr (ALIGN_EPI) { if (wr == 1) PG8_BAR; }
    }
    PG8_WAIT_V(0);
    if constexpr (!ALIGN_EPI) { if (wr == 0) PG8_BAR; }
    PG8_BAR;
    if constexpr (Epi::AFTER_DRAIN) { E.fused(acc, cur, wr, wc, fr, fq, lds, wid, lane); S.done(cur); }
#undef PG8_SA
#undef PG8_SB
#undef PG8_STAGE
#undef PG8_LDA
#undef PG8_LDB
#undef PG8_MMA
#undef PG8_WAIT_V
#undef PG8_WAIT_L
#undef PG8_BAR
#undef PG8_SCHED
}
}

#ifndef PG8_SP2
#define PG8_SP2 true
#endif
#ifndef PG8_ALIGN
#define PG8_ALIGN true
#endif
#include <hip/hip_bf16.h>
#include <cmath>
namespace attn_body {
using bf16=__hip_bfloat16;
using bf16x8=__attribute__((ext_vector_type(8)))short;
using s16x4=__attribute__((ext_vector_type(4)))short;
using f32x16=__attribute__((ext_vector_type(16)))float;
using u32x4=__attribute__((ext_vector_type(4)))unsigned;
constexpr int SEQ=2048,D=64,PQ=64,MROWS=65536;
constexpr int NW=8,QBLK=32,QB=QBLK*NW,KVBLK=64,NQB=SEQ/QB;
constexpr int ATTN_UNIT_ROWS=QB;
__device__ __forceinline__ int crow(int r,int hi){return (r&3)+8*(r>>2)+4*hi;}
#define SBAR() __builtin_amdgcn_sched_barrier(0)
__device__ __forceinline__ void cmask(f32x16&p0,f32x16&p1,int jb,int qrel,int hi){
  const float NEG=-INFINITY; int d=qrel-64*jb-4*hi; asm volatile("":"+v"(d));
  #pragma unroll
  for(int r=0;r<16;++r){const int c=(r&3)+8*(r>>2); if(c>d)p0[r]=NEG; if(c+32>d)p1[r]=NEG;}
}

constexpr int NSLOT=3, SLOTB=8192;
constexpr int LDS_K=0, LDS_V=NSLOT*SLOTB, LDS_WS=3*NSLOT*SLOTB  , LDS_OST=LDS_WS+NW*64*4, LDS_BYTES=LDS_OST+NW*4096;
constexpr float C2=0.125f*1.4426950408889634f;
__device__ __forceinline__ void glds16(const void*gsrc,unsigned lds_dst){unsigned keep;
  asm volatile("s_mov_b32 %0, m0\n\ts_mov_b32 m0, %2\n\ts_nop 0\n\tglobal_load_lds_dwordx4 %1, off\n\ts_mov_b32 m0, %0":"=&s"(keep):"v"(gsrc),"s"(lds_dst):"memory");}
__device__ __forceinline__ void glds16s(const void*sbase,unsigned voff,unsigned lds_dst){unsigned keep;
  asm volatile("s_mov_b32 %0, m0\n\ts_mov_b32 m0, %2\n\ts_nop 0\n\tglobal_load_lds_dwordx4 %1, %3\n\ts_mov_b32 m0, %0":"=&s"(keep):"v"(voff),"s"(lds_dst),"s"(sbase):"memory");}
__device__ __forceinline__ float max3f(float a,float b,float c){float r;asm("v_max3_f32 %0, %1, %2, %3":"=v"(r):"v"(a),"v"(b),"v"(c));return r;}
__device__ __forceinline__ float max2f(float a,float b){float r;asm("v_max_f32_e32 %0, %1, %2":"=v"(r):"v"(a),"v"(b));return r;}
__device__ __forceinline__ float fadd_s(float a,float b){float r;asm("v_add_f32_e32 %0, %1, %2":"=v"(r):"v"(a),"v"(b));return r;}
__device__ __forceinline__ float fsub_s(float a,float b){float r;asm("v_sub_f32_e32 %0, %1, %2":"=v"(r):"v"(a),"v"(b));return r;}
typedef float f32x4_t __attribute__((ext_vector_type(4))); typedef float f32x2_t __attribute__((ext_vector_type(2))); typedef __bf16 bf16x2_t __attribute__((ext_vector_type(2)));
__device__ __forceinline__ unsigned cvtpk_s(float lo,float hi){f32x2_t v={lo,hi};bf16x2_t b=__builtin_convertvector(v,bf16x2_t);return __builtin_bit_cast(unsigned,b);}
#define WAIT_BAR(N) asm volatile("s_waitcnt vmcnt(" #N ") lgkmcnt(0)\n\ts_barrier":::"memory")

__device__ __forceinline__ void qkt(f32x16&p0,f32x16&p1,const char*Kslot,const bf16x8*qr,const f32x16&negm,int r32,int hi){
  const char*kb=Kslot+hi*1024+r32*16;
  #pragma unroll
  for(int d0=0;d0<4;++d0){
    const bf16x8 b0=*reinterpret_cast<const bf16x8*>(kb+d0*2048);
    const bf16x8 b1=*reinterpret_cast<const bf16x8*>(kb+d0*2048+512);
    if(d0==0){p0=__builtin_amdgcn_mfma_f32_32x32x16_bf16(b0,qr[0],negm,0,0,0);p1=__builtin_amdgcn_mfma_f32_32x32x16_bf16(b1,qr[0],negm,0,0,0);}
    else{p0=__builtin_amdgcn_mfma_f32_32x32x16_bf16(b0,qr[d0],p0,0,0,0);p1=__builtin_amdgcn_mfma_f32_32x32x16_bf16(b1,qr[d0],p1,0,0,0);}}
}
typedef __attribute__((address_space(3))) const char* lds_cptr;
typedef short v4i16_t __attribute__((ext_vector_type(4)));
__device__ __forceinline__ void kload8(bf16x8*kf,lds_cptr kp){
  kf[0]=*(const __attribute__((address_space(3))) bf16x8*)(kp);      kf[1]=*(const __attribute__((address_space(3))) bf16x8*)(kp+512);
  kf[2]=*(const __attribute__((address_space(3))) bf16x8*)(kp+2048); kf[3]=*(const __attribute__((address_space(3))) bf16x8*)(kp+2560);
  kf[4]=*(const __attribute__((address_space(3))) bf16x8*)(kp+4096); kf[5]=*(const __attribute__((address_space(3))) bf16x8*)(kp+4608);
  kf[6]=*(const __attribute__((address_space(3))) bf16x8*)(kp+6144); kf[7]=*(const __attribute__((address_space(3))) bf16x8*)(kp+6656);
}
__device__ __forceinline__ void kload2(bf16x8*kf,lds_cptr kp,int j){ kf[2*j]=*(const __attribute__((address_space(3))) bf16x8*)(kp+j*2048); kf[2*j+1]=*(const __attribute__((address_space(3))) bf16x8*)(kp+j*2048+512); }
__device__ __forceinline__ s16x4 vtr(lds_cptr p){ return __builtin_bit_cast(s16x4,__builtin_amdgcn_ds_read_tr16_b64_v4i16((__attribute__((address_space(3))) v4i16_t*)p)); }
__device__ __forceinline__ float rowmax(const f32x16&p0,const f32x16&p1){
  float a=max3f(p0[0],p0[1],p1[0]),b=max3f(p0[2],p0[3],p1[1]);a=max3f(a,p1[2],p1[3]);
  #pragma unroll
  for(int r=4;r<16;r+=4){a=max3f(a,p0[r],p0[r+1]);b=max3f(b,p0[r+2],p0[r+3]);a=max3f(a,p1[r],p1[r+1]);b=max3f(b,p1[r+2],p1[r+3]);}
  const float m=max2f(a,b);
  auto rr=__builtin_amdgcn_permlane32_swap(__float_as_uint(m),__float_as_uint(m),false,false);
  return max2f(__uint_as_float(rr[0]),__uint_as_float(rr[1]));
}
__device__ __forceinline__ void pv(f32x16*o,int vb,bf16x8 pa0,bf16x8 pa1,bf16x8 pa2,bf16x8 pa3){
  #pragma unroll
  for(int d0=0;d0<2;++d0){s16x4 lo[4],hi[4];
    #pragma unroll
    for(int ks=0;ks<4;++ks){
      asm volatile("ds_read_b64_tr_b16 %0,%1 offset:%c2":"=&v"(lo[ks]):"v"(vb),"i"(d0*4096+ks*1024):"memory");
      asm volatile("ds_read_b64_tr_b16 %0,%1 offset:%c2":"=&v"(hi[ks]):"v"(vb),"i"(d0*4096+ks*1024+512):"memory");}
    asm volatile("s_waitcnt lgkmcnt(0)":::"memory");SBAR();
    #define PK(k) (bf16x8){lo[k][0],lo[k][1],lo[k][2],lo[k][3],hi[k][0],hi[k][1],hi[k][2],hi[k][3]}
    o[d0]=__builtin_amdgcn_mfma_f32_32x32x16_bf16(pa0,PK(0),o[d0],0,0,0);
    o[d0]=__builtin_amdgcn_mfma_f32_32x32x16_bf16(pa1,PK(1),o[d0],0,0,0);
    o[d0]=__builtin_amdgcn_mfma_f32_32x32x16_bf16(pa2,PK(2),o[d0],0,0,0);
    o[d0]=__builtin_amdgcn_mfma_f32_32x32x16_bf16(pa3,PK(3),o[d0],0,0,0);
    #undef PK
  }
}

#ifndef ATTN_STORE16
#define ATTN_STORE16(p,v) (*(u32x4*)(p)=(v))
#endif
__device__ __forceinline__ void attn_prefetch(const bf16*Qh,const bf16*Kh,int qb,bf16x8(&qn)[4],char*shm,const int wave_s){
  const int tid=tid_now(wave_s),lane=tid&63,r32=lane&31,hi=lane>>5; const int wid=__builtin_amdgcn_readfirstlane(tid>>6);
  const unsigned lds0=(unsigned)(uintptr_t)shm; const unsigned koff=(unsigned)((lane*PQ+wid*8)*2); const unsigned kdst=lds0+LDS_K+wid*1024;
  glds16s(Kh,koff,(unsigned)__builtin_amdgcn_readfirstlane(kdst)); glds16s(Kh+(long)KVBLK*PQ,koff,(unsigned)__builtin_amdgcn_readfirstlane(kdst+SLOTB)); glds16s(Kh+(long)2*KVBLK*PQ,koff,(unsigned)__builtin_amdgcn_readfirstlane(kdst+2*SLOTB));
  const char*Qw=(const char*)(Qh+(long)(qb*QB+wid*QBLK)*PQ); const unsigned qoff=(unsigned)((r32*PQ+hi*8)*2);
  #pragma unroll
  for(int d0=0;d0<4;++d0)qn[d0]=*reinterpret_cast<const bf16x8*>(Qw+qoff+d0*32);
}
struct EpiArgs { int mode; bf16* out; const bf16* z; const bf16* od; const float* gsub; const float* lq1; const float* lk1; const float* lq2; const float* lk2; };
template<int THRL,bool WIDE> __device__ __forceinline__ void attn_unit(int qb,bf16x8(&qr)[4],const bf16*__restrict__ Kh,const bf16*__restrict__ Vh,const EpiArgs EA,const float*kmean,const bool has_next,const bf16*Qn,const bf16*Kn,int qbn,char*shm,const int wave_s){
  const int tid=tid_now(wave_s),lane=tid&63,r32=lane&31,hi=lane>>5; const int wid=__builtin_amdgcn_readfirstlane(tid>>6);
  constexpr bool MOBA=!WIDE;
  const int q0=qb*QB;
  const unsigned lds0=(unsigned)(uintptr_t)shm;
  float*wsf=(float*)(shm+LDS_WS)+wid*64;
  const unsigned koff=(unsigned)((lane*PQ+wid*8)*2);
  const unsigned voff=(unsigned)(((16*(wid&3)+(lane>>2))*PQ+(wid>>2)*32+(lane&3)*8)*2);
  const unsigned kdst=lds0+LDS_K+wid*1024, vdst=lds0+LDS_V+wid*1024;
  #define DMA_K(t,slot) glds16s(Kh+(long)(t)*KVBLK*PQ,koff,(unsigned)__builtin_amdgcn_readfirstlane(kdst+(slot)))
  #define DMA_V(t,slot) do{ glds16s(Vh+(long)(t)*KVBLK*PQ,voff,(unsigned)__builtin_amdgcn_readfirstlane(vdst+2*(slot))); \
    if constexpr(WIDE) glds16s(Vh+(long)MROWS*64+(long)(t)*KVBLK*PQ,voff,(unsigned)__builtin_amdgcn_readfirstlane(vdst+2*(slot)+8192)); }while(0)
  #define WB(a,b) do{ if constexpr(WIDE){WAIT_BAR(b);} else {WAIT_BAR(a);} }while(0)
  const int vb0=(int)(lds0+LDS_V)+((lane>>4)&1)*32+(lane&3)*8+(4*hi+((lane&15)>>2))*64;
  const char*Kbase=shm+LDS_K; bf16x8 kf[8];
  const lds_cptr shm3=(lds_cptr)shm; const lds_cptr kp0=shm3+LDS_K+hi*1024+r32*16; const lds_cptr vp0=shm3+LDS_V+((lane>>4)&1)*32+(lane&3)*8+(4*hi+((lane&15)>>2))*64;
  const int NT=(q0+QB)/KVBLK;
  DMA_V(0,0);

  unsigned selmask=0xffu;
  if(MOBA && qb>=4){
    float g[7]; int hio=hi; asm volatile("":"+v"(hio));
    #pragma unroll
    for(int blk=0;blk<7;++blk){ float s=-INFINITY;
      if(blk<qb){ const float*km=kmean+blk*1024+hio*8; float a=0.f;
        #pragma unroll
        for(int d0=0;d0<4;++d0){ const f32x4_t ka=*reinterpret_cast<const f32x4_t*>(km+d0*16)+*reinterpret_cast<const f32x4_t*>(km+512+d0*16), kb2=*reinterpret_cast<const f32x4_t*>(km+d0*16+4)+*reinterpret_cast<const f32x4_t*>(km+512+d0*16+4);
          #pragma unroll
          for(int e=0;e<4;++e){ a+=__uint_as_float(((unsigned)(unsigned short)qr[d0][e])<<16)*ka[e]; a+=__uint_as_float(((unsigned)(unsigned short)qr[d0][4+e])<<16)*kb2[e]; } }
        s=a+__shfl_xor(a,32); }
      g[blk]=s; }
    selmask=1u<<qb;
    #pragma unroll
    for(int blk=0;blk<7;++blk){ int rank=0;
      #pragma unroll
      for(int b2=0;b2<7;++b2){ if(b2!=blk) rank+=((g[b2]>g[blk])||(g[b2]==g[blk]&&b2<blk))?1:0; }
      if(blk<qb&&rank<3) selmask|=1u<<blk; }
  }
  #define BMASK(P0,P1,t) do{ if(MOBA && (t)<NT-4){ if(!((selmask>>((t)>>2))&1u)){ _Pragma("unroll") for(int r_=0;r_<16;++r_){P0[r_]=-INFINITY;P1[r_]=-INFINITY;} } } }while(0)
  float mhat=0.f,l_reg=0.f;constexpr int NO=WIDE?4:2; f32x16 o[NO];
  #pragma unroll
  for(int d_=0;d_<NO;++d_)o[d_]=f32x16{};
  f32x16 negm=f32x16{};
  const int qrel=wid*QBLK+r32;
  #define CMASK(P0,P1,t) do{int jb_=(t)-(NT-4); if(jb_>=0)cmask(P0,P1,jb_,qrel,hi); else BMASK(P0,P1,t);}while(0)
  bool resc=false;
  #define START(P0,P1) do{ const float rm=rowmax(P0,P1); resc=false; \
    { const float dl=MOBA?__builtin_fmaxf(rm,-1000.f):rm; mhat=fadd_s(mhat,dl); \
      _Pragma("unroll") for(int r=0;r<16;++r){P0[r]=fsub_s(P0[r],dl);P1[r]=fsub_s(P1[r],dl);} \
      if constexpr(!WIDE){ _Pragma("unroll") for(int r=0;r<16;++r)negm[r]=-mhat; asm volatile("":"+v"(negm)); } } \
    _Pragma("unroll") for(int r=0;r<16;++r)P0[r]=__builtin_amdgcn_exp2f(P0[r]); }while(0)
  #define RESC() do{ if(resc){ asm volatile("s_waitcnt lgkmcnt(0)":::"memory"); \
      _Pragma("unroll") for(int d_=0;d_<NO;++d_) _Pragma("unroll") for(int r=0;r<16;++r)o[d_][r]*=wsb[(r&3)+8*(r>>2)]; } }while(0)
  typedef __attribute__((address_space(3))) const float* lds_fptr; const lds_fptr wsb=(lds_fptr)(shm3+LDS_WS)+wid*64+4*hi;
  f32x16 pA0,pA1,pB0,pB1; u32x4 pw0,pw1,pw2,pw3;
  u32x4 qw0,qw1,qw2,qw3; float sacc_c=0.f;
  int sl_prev=0,sl_cur=0,sl_next=SLOTB;
  #define ROT() do{sl_prev=sl_cur;sl_cur=sl_next;sl_next=(sl_next==(NSLOT-1)*SLOTB)?0:sl_next+SLOTB;}while(0)
  WB(1,2);
  qkt(pA0,pA1,Kbase,qr,negm,r32,hi);asm volatile("s_nop 15\n\ts_nop 7":"+v"(pA0),"+v"(pA1));CMASK(pA0,pA1,0);
  START(pA0,pA1);
  _Pragma("unroll") for(int r=0;r<16;++r)pA1[r]=__builtin_amdgcn_exp2f(pA1[r]);
  if constexpr(WIDE){ float s0_=pA0[0]+pA0[1]; _Pragma("unroll") for(int r=2;r<16;++r)s0_+=pA0[r]; _Pragma("unroll") for(int r=0;r<16;++r)s0_+=pA1[r]; sacc_c=s0_;
    pw0=(u32x4){cvtpk_s(pA0[0],pA0[1]),cvtpk_s(pA0[2],pA0[3]),cvtpk_s(pA0[4],pA0[5]),cvtpk_s(pA0[6],pA0[7])};pw1=(u32x4){cvtpk_s(pA0[8],pA0[9]),cvtpk_s(pA0[10],pA0[11]),cvtpk_s(pA0[12],pA0[13]),cvtpk_s(pA0[14],pA0[15])};
    pw2=(u32x4){cvtpk_s(pA1[0],pA1[1]),cvtpk_s(pA1[2],pA1[3]),cvtpk_s(pA1[4],pA1[5]),cvtpk_s(pA1[6],pA1[7])};pw3=(u32x4){cvtpk_s(pA1[8],pA1[9]),cvtpk_s(pA1[10],pA1[11]),cvtpk_s(pA1[12],pA1[13]),cvtpk_s(pA1[14],pA1[15])}; }
  WAIT_BAR(0);
  DMA_K(3,0);DMA_V(1,SLOTB);
  ROT();
  kload8(kf,kp0+sl_cur);
  WB(2,3);
  s16x4 vlo[8],vhi[8];
  #define PKW(P,B) cvtpk_s(P[B],P[B+1])
  #define PAF(k) __builtin_bit_cast(bf16x8,pw##k)
  #define PAFX(S,k) __builtin_bit_cast(bf16x8,S##k)
  #define SP(X,B,PW,c) do{ sacc_c+=X[B]; sacc_c+=X[B+1]; PW[c]=PKW(X,B); PIN(sacc_c); PIN(PW); }while(0)
  #define GW(MF,X,B,SPX) do{ MF; X[B]=EX(X[B]); X[B+1]=EX(X[B+1]); SPX; SBAR(); }while(0)
  #define VFR(i) (bf16x8){vlo[i][0],vlo[i][1],vlo[i][2],vlo[i][3],vhi[i][0],vhi[i][1],vhi[i][2],vhi[i][3]}
  #define PIN(x) asm volatile("":"+v"(x))
  #define MX3(a,b,c) __builtin_fmaxf(__builtin_fmaxf((a),(b)),(c))
  #define GAPA(MF,A0,A1,A2,A3,W0,W1,PW) do{ MF; sacc+=A0; sacc+=A1; sacc+=A2; sacc+=A3; PIN(sacc); W0; W1; PIN(PW); SBAR(); }while(0)
  #define EX(v) __builtin_amdgcn_exp2f(v)
  #define GAPB(MF,X,B) do{ MF; X[B]=EX(X[B]); X[B+1]=EX(X[B+1]); X[B+2]=EX(X[B+2]); X[B+3]=EX(X[B+3]); PIN(X); SBAR(); }while(0)
  #define VRD(i) do{ vlo[i]=vtr(vp_+(((i)>>2)*4096+((i)&3)*1024)); vhi[i]=vtr(vp_+(((i)>>2)*4096+((i)&3)*1024+512)); }while(0)
  #define KRD(G,j) do{ if(G){ kload2(kf,kp0+sl_next,j); SBAR(); } }while(0)
  #define VRD2(i) do{ if constexpr(WIDE){ vlo[i]=vtr(vp_+8192+(((i)>>2)*4096+((i)&3)*1024)); vhi[i]=vtr(vp_+8192+(((i)>>2)*4096+((i)&3)*1024+512)); SBAR(); } }while(0)
  #define STEP(C0,C1,P0,P1,t,GK,GV,GL,PWC,PWN) do{ SBAR(); \
    const lds_cptr vp_=vp0+2*sl_prev; \
    float sacc=0.f; if constexpr(!WIDE) sacc=(P0[0]+P0[1]); \
    if constexpr(WIDE){   \
      VRD(0); SBAR(); C0=__builtin_amdgcn_mfma_f32_32x32x16_bf16(kf[0],qr[0],negm,0,0,0); SBAR(); \
      VRD(4); SBAR(); C1=__builtin_amdgcn_mfma_f32_32x32x16_bf16(kf[1],qr[0],negm,0,0,0); SBAR(); \
      VRD(1); SBAR(); C0=__builtin_amdgcn_mfma_f32_32x32x16_bf16(kf[2],qr[1],C0,0,0,0); SBAR(); \
      VRD(5); SBAR(); C1=__builtin_amdgcn_mfma_f32_32x32x16_bf16(kf[3],qr[1],C1,0,0,0); SBAR(); \
      VRD(2); SBAR(); C0=__builtin_amdgcn_mfma_f32_32x32x16_bf16(kf[4],qr[2],C0,0,0,0); SBAR(); \
      VRD(6); SBAR(); C1=__builtin_amdgcn_mfma_f32_32x32x16_bf16(kf[5],qr[2],C1,0,0,0); SBAR(); \
      VRD(3); SBAR(); C0=__builtin_amdgcn_mfma_f32_32x32x16_bf16(kf[6],qr[3],C0,0,0,0); SBAR(); \
      VRD(7); SBAR(); C1=__builtin_amdgcn_mfma_f32_32x32x16_bf16(kf[7],qr[3],C1,0,0,0); SBAR(); \
    } else { \
    VRD(0); SBAR(); \
    GAPA(C0=__builtin_amdgcn_mfma_f32_32x32x16_bf16(kf[0],qr[0],negm,0,0,0), P0[2],P0[3],P0[4],P0[5],     pw0[0]=PKW(P0,0), pw0[1]=PKW(P0,2), pw0); \
    VRD(4); SBAR(); GAPA(C1=__builtin_amdgcn_mfma_f32_32x32x16_bf16(kf[1],qr[0],negm,0,0,0), P0[6],P0[7],P0[8],P0[9],     pw0[2]=PKW(P0,4), pw0[3]=PKW(P0,6), pw0); \
    VRD(1); SBAR(); GAPA(C0=__builtin_amdgcn_mfma_f32_32x32x16_bf16(kf[2],qr[1],C0,0,0,0),   P0[10],P0[11],P0[12],P0[13], pw1[0]=PKW(P0,8), pw1[1]=PKW(P0,10), pw1); \
    VRD(5); SBAR(); GAPA(C1=__builtin_amdgcn_mfma_f32_32x32x16_bf16(kf[3],qr[1],C1,0,0,0),   P0[14],P0[15],P1[0],P1[1],   pw1[2]=PKW(P0,12),pw1[3]=PKW(P0,14), pw1); \
    VRD(2); SBAR(); GAPA(C0=__builtin_amdgcn_mfma_f32_32x32x16_bf16(kf[4],qr[2],C0,0,0,0),   P1[2],P1[3],P1[4],P1[5],     pw2[0]=PKW(P1,0), pw2[1]=PKW(P1,2), pw2); \
    VRD(6); SBAR(); GAPA(C1=__builtin_amdgcn_mfma_f32_32x32x16_bf16(kf[5],qr[2],C1,0,0,0),   P1[6],P1[7],P1[8],P1[9],     pw2[2]=PKW(P1,4), pw2[3]=PKW(P1,6), pw2); \
    VRD(3); SBAR(); GAPA(C0=__builtin_amdgcn_mfma_f32_32x32x16_bf16(kf[6],qr[3],C0,0,0,0),   P1[10],P1[11],P1[12],P1[13], pw3[0]=PKW(P1,8), pw3[1]=PKW(P1,10), pw3); \
    VRD(7); SBAR(); GAPA(C1=__builtin_amdgcn_mfma_f32_32x32x16_bf16(kf[7],qr[3],C1,0,0,0),   P1[14],P1[15],0.f,0.f,       pw3[2]=PKW(P1,12),pw3[3]=PKW(P1,14), pw3); \
    } \
    if constexpr(WIDE){ l_reg+=sacc_c; sacc_c=0.f; } else { l_reg+=sacc; } \
    if(GK){DMA_K((t)+3,sl_cur);} if(GV){DMA_V((t)+1,sl_next);} \
    CMASK(C0,C1,t); \
    if constexpr(WIDE){ _Pragma("unroll") for(int r=0;r<16;++r){C0[r]-=mhat;C1[r]-=mhat;} } \
    { float a=MX3(C0[0],C0[1],C1[0]),b=MX3(C0[2],C0[3],C1[1]); a=MX3(a,C1[2],C1[3]); \
      _Pragma("unroll") for(int r=4;r<16;r+=4){a=MX3(a,C0[r],C0[r+1]);b=MX3(b,C0[r+2],C0[r+3]);a=MX3(a,C1[r],C1[r+1]);b=MX3(b,C1[r+2],C1[r+3]);} \
      float rm=__builtin_fmaxf(a,b); { auto rr=__builtin_amdgcn_permlane32_swap(__float_as_uint(rm),__float_as_uint(rm),false,false); rm=__builtin_fmaxf(__uint_as_float(rr[0]),__uint_as_float(rr[1])); } \
      resc=false; \
      if(__builtin_expect(__any(rm>(float)THRL),0)){ const float dl=__builtin_fmaxf(rm,0.f); mhat+=dl; \
        _Pragma("unroll") for(int r=0;r<16;++r){C0[r]-=dl;C1[r]-=dl;} \
        if constexpr(!WIDE){ _Pragma("unroll") for(int r=0;r<16;++r)negm[r]=-mhat; asm volatile("":"+v"(negm)); } \
        const float f=__builtin_amdgcn_exp2f(-dl); l_reg*=f; if(hi==0)wsf[r32]=f; resc=true; } } \
    SBAR(); \
    if constexpr(WIDE){ \
      GW(o[0]=__builtin_amdgcn_mfma_f32_32x32x16_bf16(PAFX(PWC,0),VFR(0),o[0],0,0,0), C0,0,  (void)0); VRD2(0); \
      GW(o[1]=__builtin_amdgcn_mfma_f32_32x32x16_bf16(PAFX(PWC,0),VFR(4),o[1],0,0,0), C0,4,  SP(C0,0,PWN##0,0)); VRD2(4); \
      GW(o[0]=__builtin_amdgcn_mfma_f32_32x32x16_bf16(PAFX(PWC,1),VFR(1),o[0],0,0,0), C0,8,  SP(C0,4,PWN##0,2)); VRD2(1); \
      GW(o[1]=__builtin_amdgcn_mfma_f32_32x32x16_bf16(PAFX(PWC,1),VFR(5),o[1],0,0,0), C0,12, SP(C0,8,PWN##1,0)); VRD2(5); \
      GW(o[0]=__builtin_amdgcn_mfma_f32_32x32x16_bf16(PAFX(PWC,2),VFR(2),o[0],0,0,0), C1,0,  SP(C0,12,PWN##1,2)); VRD2(2); \
      GW(o[1]=__builtin_amdgcn_mfma_f32_32x32x16_bf16(PAFX(PWC,2),VFR(6),o[1],0,0,0), C1,4,  SP(C1,0,PWN##2,0)); VRD2(6); \
      GW(o[0]=__builtin_amdgcn_mfma_f32_32x32x16_bf16(PAFX(PWC,3),VFR(3),o[0],0,0,0), C1,8,  SP(C1,4,PWN##2,2)); VRD2(3); \
      GW(o[1]=__builtin_amdgcn_mfma_f32_32x32x16_bf16(PAFX(PWC,3),VFR(7),o[1],0,0,0), C1,12, SP(C1,8,PWN##3,0)); VRD2(7); \
        \
      GW(o[2]=__builtin_amdgcn_mfma_f32_32x32x16_bf16(PAFX(PWC,0),VFR(0),o[2],0,0,0), C0,2,  SP(C1,12,PWN##3,2)); \
      GW(o[3]=__builtin_amdgcn_mfma_f32_32x32x16_bf16(PAFX(PWC,0),VFR(4),o[3],0,0,0), C0,6,  SP(C0,2,PWN##0,1)); \
      KRD(GL,0); GW(o[2]=__builtin_amdgcn_mfma_f32_32x32x16_bf16(PAFX(PWC,1),VFR(1),o[2],0,0,0), C0,10, SP(C0,6,PWN##0,3)); \
      KRD(GL,1); GW(o[3]=__builtin_amdgcn_mfma_f32_32x32x16_bf16(PAFX(PWC,1),VFR(5),o[3],0,0,0), C0,14, SP(C0,10,PWN##1,1)); \
      KRD(GL,2); GW(o[2]=__builtin_amdgcn_mfma_f32_32x32x16_bf16(PAFX(PWC,2),VFR(2),o[2],0,0,0), C1,2,  SP(C0,14,PWN##1,3)); \
      KRD(GL,3); GW(o[3]=__builtin_amdgcn_mfma_f32_32x32x16_bf16(PAFX(PWC,2),VFR(6),o[3],0,0,0), C1,6,  SP(C1,2,PWN##2,1)); \
      GW(o[2]=__builtin_amdgcn_mfma_f32_32x32x16_bf16(PAFX(PWC,3),VFR(3),o[2],0,0,0), C1,10, SP(C1,6,PWN##2,3)); \
      GW(o[3]=__builtin_amdgcn_mfma_f32_32x32x16_bf16(PAFX(PWC,3),VFR(7),o[3],0,0,0), C1,14, SP(C1,10,PWN##3,1)); \
      SP(C1,14,PWN##3,3); SBAR(); \
    } else { \
    GAPB(o[0]=__builtin_amdgcn_mfma_f32_32x32x16_bf16(PAF(0),VFR(0),o[0],0,0,0), C0,0); VRD2(0); \
    GAPB(o[1]=__builtin_amdgcn_mfma_f32_32x32x16_bf16(PAF(0),VFR(4),o[1],0,0,0), C0,4); VRD2(4); \
    KRD(GL,0); GAPB(o[0]=__builtin_amdgcn_mfma_f32_32x32x16_bf16(PAF(1),VFR(1),o[0],0,0,0), C0,8); VRD2(1); \
    KRD(GL,1); GAPB(o[1]=__builtin_amdgcn_mfma_f32_32x32x16_bf16(PAF(1),VFR(5),o[1],0,0,0), C0,12); VRD2(5); \
    KRD(GL,2); GAPB(o[0]=__builtin_amdgcn_mfma_f32_32x32x16_bf16(PAF(2),VFR(2),o[0],0,0,0), C1,0); VRD2(2); \
    KRD(GL,3); GAPB(o[1]=__builtin_amdgcn_mfma_f32_32x32x16_bf16(PAF(2),VFR(6),o[1],0,0,0), C1,4); VRD2(6); \
    GAPB(o[0]=__builtin_amdgcn_mfma_f32_32x32x16_bf16(PAF(3),VFR(3),o[0],0,0,0), C1,8); VRD2(3); \
    GAPB(o[1]=__builtin_amdgcn_mfma_f32_32x32x16_bf16(PAF(3),VFR(7),o[1],0,0,0), C1,12); VRD2(7); \
    } \
    }while(0)
  int t=1;
  #undef CMASK
  #define CMASK(P0,P1,t) BMASK(P0,P1,t)
  for(;t+5<NT;t+=2){
    STEP(pB0,pB1,pA0,pA1,t,true,true,true,pw,qw);     WB(2,3); RESC(); ROT();
    STEP(pA0,pA1,pB0,pB1,t+1,true,true,true,qw,pw);   WB(2,3); RESC(); ROT();
  }
  #undef CMASK
  #define CMASK(P0,P1,t) do{int jb_=(t)-(NT-4); if(jb_>=0)cmask(P0,P1,jb_,qrel,hi); else BMASK(P0,P1,t);}while(0)
  #define ENDW(tt) do{ if((tt)+3<NT){WB(2,3);} else if((tt)+2<NT){WB(1,2);} else {WAIT_BAR(0);} }while(0)
  for(;t+1<NT;t+=2){
    STEP(pB0,pB1,pA0,pA1,t,(t+3<NT),(t+1<NT),(t+1<NT),pw,qw);       ENDW(t);   RESC(); ROT();
    STEP(pA0,pA1,pB0,pB1,t+1,(t+4<NT),(t+2<NT),(t+2<NT),qw,pw);     ENDW(t+1); RESC(); ROT();
  }
  STEP(pB0,pB1,pA0,pA1,NT-1,false,false,false,pw,qw); RESC();
  int le=lane; asm volatile("":"+v"(le)); const int r32e=le&31,hie=le>>5;
  if(has_next) attn_prefetch(Qn,Kn,qbn,qr,shm,wave_s);
  const long orow0=(long)(q0+wid*QBLK)*1024;
  u32x4 pz[4][2],po[4][2];
  #pragma unroll
  for(int i=0;i<4;++i){ pz[i][0]=u32x4{};pz[i][1]=u32x4{};po[i][0]=u32x4{};po[i][1]=u32x4{}; }
  if(EA.mode!=1){
    #pragma unroll
    for(int i=0;i<4;++i){ const bf16*zp=EA.z+orow0+(long)(i*8+(le>>3))*1024+(le&7)*8; pz[i][0]=*(const u32x4*)(zp); if(EA.mode==2)pz[i][1]=*(const u32x4*)(zp+64); }
    if(EA.mode==2){
      #pragma unroll
      for(int i=0;i<4;++i){ const bf16*odp=EA.od+orow0+(long)(i*8+(le>>3))*1024+(le&7)*8; po[i][0]=*(const u32x4*)(odp); po[i][1]=*(const u32x4*)(odp+64); } }
  }
  if constexpr(WIDE){ l_reg+=sacc_c; SBAR(); pv(o,vb0+2*sl_cur,PAFX(qw,0),PAFX(qw,1),PAFX(qw,2),PAFX(qw,3)); pv(o+2,vb0+2*sl_cur+8192,PAFX(qw,0),PAFX(qw,1),PAFX(qw,2),PAFX(qw,3)); }
  else
  { float sacc=pB0[0]+pB0[1]; _Pragma("unroll") for(int r=2;r<16;++r)sacc+=pB0[r]; _Pragma("unroll") for(int r=0;r<16;++r)sacc+=pB1[r]; l_reg+=sacc;
    pw0=(u32x4){PKW(pB0,0),PKW(pB0,2),PKW(pB0,4),PKW(pB0,6)};pw1=(u32x4){PKW(pB0,8),PKW(pB0,10),PKW(pB0,12),PKW(pB0,14)};pw2=(u32x4){PKW(pB1,0),PKW(pB1,2),PKW(pB1,4),PKW(pB1,6)};pw3=(u32x4){PKW(pB1,8),PKW(pB1,10),PKW(pB1,12),PKW(pB1,14)};
    SBAR(); pv(o,vb0+2*sl_cur,PAF(0),PAF(1),PAF(2),PAF(3)); }
  #undef PKW
  #undef PAF
  #undef VFR
  #undef PIN
  #undef MX3
  #undef GAPA
  #undef GAPB
  #undef GW
  #undef SP
  #undef PAFX
  #undef EX
  #undef VRD
  #undef KRD
  #undef VRD2
  #undef STEP
  #undef ENDW
  {auto rr=__builtin_amdgcn_permlane32_swap(__float_as_uint(l_reg),__float_as_uint(l_reg),false,false);l_reg=__uint_as_float(rr[0])+__uint_as_float(rr[1]);}
  if(hie==0)wsf[32+r32e]=l_reg;asm volatile("s_waitcnt lgkmcnt(0)":::"memory");
  float rli[16];
  #pragma unroll
  for(int r=0;r<16;++r)rli[r]=__builtin_amdgcn_rcpf(wsf[32+crow(r,hie)]);
  { bf16*stg=(bf16*)(shm+LDS_OST)+wid*2048;
    #define BFLO(u) __uint_as_float((u)<<16)
    #define BFHI(u) __uint_as_float((u)&0xffff0000u)
    #pragma unroll
    for(int r=0;r<16;++r){const int orow=crow(r,hie);
      #pragma unroll
      for(int d0=0;d0<2;++d0)stg[orow*64+d0*32+r32e]=__float2bfloat16(o[d0][r]*rli[r]);}
    asm volatile("s_waitcnt lgkmcnt(0)":::"memory");
    if constexpr(!WIDE){
      #pragma unroll
      for(int i=0;i<4;++i){const int row=i*8+(le>>3),ch=le&7; const u32x4 v=*(const u32x4*)(stg+row*64+ch*8); const u32x4 zz=pz[i][0]; u32x4 y;
        #pragma unroll
        for(int e=0;e<4;++e) y[e]=cvtpk_s(BFLO(v[e])*BFLO(zz[e]),BFHI(v[e])*BFHI(zz[e]));
        ATTN_STORE16(EA.out+orow0+(long)row*1024+ch*8,y);}
    } else {
      u32x4 va[4];
      #pragma unroll
      for(int i=0;i<4;++i){const int row=i*8+(le>>3),ch=le&7; va[i]=*(const u32x4*)(stg+row*64+ch*8); if(EA.mode==1)ATTN_STORE16(EA.out+orow0+(long)row*1024+ch*8,va[i]);}
      asm volatile("s_waitcnt lgkmcnt(0)":::"memory");
      #pragma unroll
      for(int r=0;r<16;++r){const int orow=crow(r,hie);
        #pragma unroll
        for(int d0=0;d0<2;++d0)stg[orow*64+d0*32+r32e]=__float2bfloat16(o[2+d0][r]*rli[r]);}
      asm volatile("s_waitcnt lgkmcnt(0)":::"memory");
      if(EA.mode==1){
        #pragma unroll
        for(int i=0;i<4;++i){const int row=i*8+(le>>3),ch=le&7; const u32x4 v=*(const u32x4*)(stg+row*64+ch*8); ATTN_STORE16(EA.out+orow0+(long)row*1024+64+ch*8,v);}
      } else {
        float t1=EA.lq1[le]*EA.lk1[le],t2=EA.lq2[le]*EA.lk2[le];
        #pragma unroll
        for(int o_=1;o_<64;o_<<=1){t1+=__shfl_xor(t1,o_);t2+=__shfl_xor(t2,o_);}
        const float lam=__expf(t1)-__expf(t2)+0.2f;
        #pragma unroll
        for(int i=0;i<4;++i){const int row=i*8+(le>>3),ch=le&7; const u32x4 vb=*(const u32x4*)(stg+row*64+ch*8); const u32x4 v0=va[i];
          const u32x4 o00=po[i][0],o01=po[i][1]; const u32x4 za=pz[i][0],zb=pz[i][1];
          float a[8],b[8]; float ss=0.f;
          #pragma unroll
          for(int e=0;e<4;++e){ a[2*e]=BFLO(o00[e])-lam*BFLO(v0[e]); a[2*e+1]=BFHI(o00[e])-lam*BFHI(v0[e]); b[2*e]=BFLO(o01[e])-lam*BFLO(vb[e]); b[2*e+1]=BFHI(o01[e])-lam*BFHI(vb[e]); }
          #pragma unroll
          for(int e=0;e<8;++e) ss+=a[e]*a[e]+b[e]*b[e];
          ss+=__shfl_xor(ss,1); ss+=__shfl_xor(ss,2); ss+=__shfl_xor(ss,4);
          const float rs=__builtin_amdgcn_rsqf(ss*(1.f/128.f)+1e-6f)*0.8f;
          const f32x4_t ga0=*reinterpret_cast<const f32x4_t*>(EA.gsub+ch*8),ga1=*reinterpret_cast<const f32x4_t*>(EA.gsub+ch*8+4),gb0=*reinterpret_cast<const f32x4_t*>(EA.gsub+64+ch*8),gb1=*reinterpret_cast<const f32x4_t*>(EA.gsub+64+ch*8+4);
          u32x4 ya,yb;
          #pragma unroll
          for(int e=0;e<4;++e){ const float g0=(e<2)?ga0[2*e]:ga1[2*e-4], g1=(e<2)?ga0[2*e+1]:ga1[2*e-3], h0=(e<2)?gb0[2*e]:gb1[2*e-4], h1=(e<2)?gb0[2*e+1]:gb1[2*e-3];
            ya[e]=cvtpk_s(a[2*e]*rs*g0*BFLO(za[e]),a[2*e+1]*rs*g1*BFHI(za[e])); yb[e]=cvtpk_s(b[2*e]*rs*h0*BFLO(zb[e]),b[2*e+1]*rs*h1*BFHI(zb[e])); }
          ATTN_STORE16(EA.out+orow0+(long)row*1024+ch*8,ya); ATTN_STORE16(EA.out+orow0+(long)row*1024+64+ch*8,yb);}
      }
    }
    #undef BFLO
    #undef BFHI
  }
  asm volatile("s_waitcnt lgkmcnt(0)\n\ts_barrier":::"memory");
  #undef DMA_K
  #undef DMA_V
  #undef WB
  #undef CMASK
  #undef BMASK
  #undef START
  #undef RESC
  #undef ROT
}
constexpr int ATTN_LDS_BYTES=LDS_BYTES;
struct AttnArgs { const bf16* proj; const bf16* z; bf16* y; bf16* od; const float* kmean; const float* gsub; const float* lq1; const float* lk1; const float* lq2; const float* lk2; };
__device__ __forceinline__ void attn_geom(int i,int j,const bf16*base,const bf16*&q,const bf16*&k,const bf16*&vv,int&qb){
  const bool mb=i<8; const int d=i-8,h=d>>1,mp=d&1; qb=((mb?i:h)&1)?7-j:j;
  const int gq=mb?i:24+h*2+mp, gk=mb?8+i:32+h*2+mp, gv=mb?16+i:40+h*2;
  q=base+(long)gq*MROWS*64; k=base+(long)gk*MROWS*64; vv=base+(long)gv*MROWS*64;
}
template<int THRL=8> __device__ __forceinline__ void attn_phase(char*lds,const AttnArgs&T,int vcu,int G,const int wave_s){
  for(int v=vcu;v<256;v+=G){
    const int g=v>>3,j=v&7; const bf16*base=T.proj+(long)g*SEQ*PQ;
    const long rb=(long)g*SEQ*1024;
    bf16x8 qr[4]; const bf16*q,*k,*vv; int qb; attn_geom(0,j,base,q,k,vv,qb);
    attn_prefetch(q,k,qb,qr,lds,wave_s);
    for(int i=0;i<16;++i){ const bool mb=i<8; const int d=i-8,h=d>>1,mp=d&1;
      attn_geom(i,j,base,q,k,vv,qb);
      const bf16*qn,*kn,*vn; int qbn; attn_geom(i<15?i+1:15,j,base,qn,kn,vn,qbn);
      EpiArgs EA; EA.mode=mb?0:(mp?2:1);
      EA.out=mb?T.y+rb+i*64:(mp?T.y+rb+512+h*128:T.od+rb+h*256);
      EA.z=mb?T.z+rb+i*64:T.z+rb+512+h*128; EA.od=T.od+rb+h*256; EA.gsub=T.gsub; EA.lq1=T.lq1; EA.lk1=T.lk1; EA.lq2=T.lq2; EA.lk2=T.lk2;
      if(mb) attn_unit<THRL,false>(qb,qr,k,vv,EA,T.kmean+g*8192+(i&7)*64,true,qn,kn,qbn,lds,wave_s);
      else   attn_unit<THRL,true>(qb,qr,k,vv,EA,T.kmean,i<15,qn,kn,qbn,lds,wave_s); }
  }
}
#undef SBAR
#undef WAIT_BAR
}
constexpr int NWAVES = 8;
#ifndef MK_N_LAUNCHES
#define MK_N_LAUNCHES 1
#endif
constexpr int N_PHASES = 8;
constexpr int N_LAUNCHES = MK_N_LAUNCHES;
constexpr int BATCH = 32, SEQ = 2048, D = 1024, PLE = 256, PROJ = 4096;
constexpr int M = BATCH * SEQ;
constexpr float EPS = 1e-6f;
constexpr size_t MiB = 1u << 20;
constexpr size_t WS_WIN = 2 * MiB, WS_WOUT = 10 * MiB, WS_WG = 12 * MiB, WS_WPLE = 14 * MiB;
constexpr size_t WS_ROPE = 15 * MiB;
constexpr size_t WS_KMEAN = 16 * MiB;
constexpr size_t WS_CNT = 1 * MiB;
constexpr size_t WS_PART = 20 * MiB;
constexpr size_t WS_PART2 = 24 * MiB;
constexpr size_t WS_PROJ = 32 * MiB;
constexpr size_t WS_Z = 416 * MiB;
constexpr size_t WS_HB = 32 * MiB, WS_PE = 160 * MiB;
constexpr size_t WS_XN = 544 * MiB;
constexpr size_t WS_OM = 672 * MiB;
constexpr size_t WS_OD = 736 * MiB;
constexpr size_t WS_PB = 864 * MiB;
constexpr size_t WS_END = 896 * MiB;
constexpr int RING_OFF = 0, RING_BYTES = 131072;
constexpr int LDS_BYTES = 147456;

#define GAS __attribute__((address_space(1)))
#define LAS __attribute__((address_space(3)))
typedef unsigned short bf16;
typedef unsigned v4u __attribute__((ext_vector_type(4)));
typedef float f32x4 __attribute__((ext_vector_type(4)));
#define LDS_WAIT() asm volatile("s_waitcnt lgkmcnt(0)" ::: "memory")
__device__ __forceinline__ unsigned f2bf(float f) { unsigned u = __builtin_bit_cast(unsigned, f); return (u + 0x7fffu + ((u >> 16) & 1u)) >> 16; }
__device__ __forceinline__ unsigned pk2(float lo, float hi) { return f2bf(lo) | (f2bf(hi) << 16); }
__device__ __forceinline__ float bflo(unsigned u) { return __uint_as_float(u << 16); }
__device__ __forceinline__ float bfhi(unsigned u) { return __uint_as_float(u & 0xffff0000u); }

typedef GAS unsigned gu32;
#define RLX_AGENT __ATOMIC_RELAXED, __HIP_MEMORY_SCOPE_AGENT
#define XB_TMO      128
#define XB_XCNT(j)  (256  + 64 * (j))
#define XB_XSUB(j)  (1280 + 64 * (j))
#define XB_XGEN(j)  (2304 + 64 * (j))
#define XB_TOP      3328
#define XB_TOPGEN   3392
#define XCD_BAR_WORDS 3456
#define XB_SPIN_CAP (1u << 18)

__device__ __forceinline__ unsigned xb_ld(unsigned* p)              { return __hip_atomic_load(p, __ATOMIC_RELAXED, __HIP_MEMORY_SCOPE_AGENT); }
__device__ __forceinline__ unsigned xb_add(unsigned* p, unsigned v) { return __hip_atomic_fetch_add(p, v, __ATOMIC_RELAXED, __HIP_MEMORY_SCOPE_AGENT); }
__device__ __forceinline__ unsigned xb_xcc_id() { return (unsigned)__builtin_amdgcn_s_getreg((3 << 11) | 20) & 0xFu; }
#define XB_SPIN(cond, bar) do { unsigned _sp = 0; while (cond) { __builtin_amdgcn_s_sleep(1); \
    if ((++_sp & 255u) == 0u) { if (xb_ld(&(bar)[XB_TMO])) break; if (_sp > XB_SPIN_CAP) { atomicAdd(&(bar)[XB_TMO], 1u); break; } } } } while (0)

struct XcdBarrier {
    unsigned* bar; unsigned x;
    volatile LAS unsigned* st;
};

__device__ __forceinline__ XcdBarrier xcd_barrier_post(unsigned* bar, volatile LAS unsigned* st, const int tid_) {
    XcdBarrier b; b.bar = bar; b.x = xb_xcc_id(); b.st = st;
    if (tid_ == 0) (void)xb_add(&bar[XB_XCNT(b.x)], 1u);
    return b;
}
__device__ __forceinline__ void xcd_barrier_complete(unsigned* bar, unsigned x, unsigned& nloc, unsigned& nx) {
    const unsigned G = gridDim.x * gridDim.y * gridDim.z;
    unsigned sum, cnt, mine, sp = 0u;
    for (;;) {
        sum = 0u; cnt = 0u; mine = 0u;
#pragma unroll
        for (unsigned j = 0; j < 16; ++j) { const unsigned c = xb_ld(&bar[XB_XCNT(j)]); sum += c; cnt += (c > 0u) ? 1u : 0u; mine = (j == x) ? c : mine; }
        if (sum == G) break;
        __builtin_amdgcn_s_sleep(1);
        if ((++sp & 255u) == 0u) { if (xb_ld(&bar[XB_TMO])) break; if (sp > XB_SPIN_CAP) { atomicAdd(&bar[XB_TMO], 1u); break; } }
    }
    nloc = mine > 0u ? mine : 1u; nx = cnt > 0u ? cnt : 1u;
}

__device__ __forceinline__ void xcd_barrier(const XcdBarrier& b, const int tid_) {
    asm volatile("s_waitcnt vmcnt(0)" ::: "memory");
    __syncthreads();
    if (tid_ == 0) {
        unsigned* bar = b.bar;
        __builtin_amdgcn_s_waitcnt(0);
        unsigned nloc = b.st[0], nx = b.st[1];
        if (nloc == 0u) { xcd_barrier_complete(bar, b.x, nloc, nx); b.st[0] = nloc; b.st[1] = nx; }
        const unsigned old = xb_add(&bar[XB_XSUB(b.x)], 1u);
        const unsigned gen = old / nloc;
        if (old + 1u == (gen + 1u) * nloc) {
            __builtin_amdgcn_fence(__ATOMIC_RELEASE, "agent");
            asm volatile("s_waitcnt vmcnt(0)" ::: "memory");
            const unsigned og = xb_add(&bar[XB_TOP], 1u);
            const unsigned tg = og / nx;
            if (og + 1u == (tg + 1u) * nx) xb_add(&bar[XB_TOPGEN], 1u);
            else XB_SPIN(xb_ld(&bar[XB_TOPGEN]) == tg, bar);
            __builtin_amdgcn_fence(__ATOMIC_ACQUIRE, "agent");
            xb_add(&bar[XB_XGEN(b.x)], 1u);
            asm volatile("s_waitcnt vmcnt(0)" ::: "memory");
        } else {
            XB_SPIN(xb_ld(&bar[XB_XGEN(b.x)]) == gen, bar);
            __builtin_amdgcn_fence(__ATOMIC_ACQUIRE, "agent");
            asm volatile("s_waitcnt vmcnt(0)" ::: "memory");
        }
    }
    __syncthreads();
}

struct Frame {
    LAS unsigned char* lds;
    int tid, lane, wave, vcu, G;
    const float *x, *p, *w_in, *w_out, *g_mix, *lq1, *lk1, *lq2, *lk2, *g_subln, *w_ple, *w_gate, *g_ple, *g_final; float* out;
    bf16 *WinT, *WoutT, *WgT, *WpleT, *PROJB, *ZB, *HB, *PE, *XN, *OM, *OD, *PB;
    float *ROPE, *KMEAN, *PART, *PART2; unsigned* CNT;
};
__device__ __forceinline__ float wave_sum(float v) {
#pragma unroll
    for (int o = 1; o < 64; o <<= 1) v += __shfl_xor(v, o);
    return v;
}
__device__ __forceinline__ void p0_transpose_item(const float* W, int K, int N, bf16* WT, const float* kscale, LAS float* scr, int item, int lane, bool perm64 = false) {
    const int nblk = N / 32, kb = item / nblk, nb = item % nblk, k0 = 64 * kb, n0 = 32 * nb;
    const int n0w = perm64 ? (nb >> 3) * 256 + (nb & 1) * 128 + ((nb & 7) >> 1) * 32 : n0;
#pragma unroll 8
    for (int i = 0; i < 32; ++i) { const int kk = 2 * i + (lane >> 5); float w = W[(size_t)(k0 + kk) * N + n0 + (lane & 31)]; if (kscale) w *= kscale[k0 + kk]; scr[kk * 33 + (lane & 31)] = w; }
    LDS_WAIT(); asm volatile("" ::: "memory");
    const int c = lane & 7;
#pragma unroll
    for (int j = 0; j < 4; ++j) { const int n = (lane >> 3) + 8 * j; const LAS float* s = scr + (8 * c) * 33 + n;
        v4u o; o.x = pk2(s[0 * 33], s[1 * 33]); o.y = pk2(s[2 * 33], s[3 * 33]); o.z = pk2(s[4 * 33], s[5 * 33]); o.w = pk2(s[6 * 33], s[7 * 33]);
        *(GAS v4u*)(WT + (size_t)(n0w + n) * K + k0 + 8 * c) = o; }
    LDS_WAIT(); asm volatile("" ::: "memory");
}
__device__ __forceinline__ void p0_prologue(Frame& F) {
    LAS float* scr = (LAS float*)(F.lds + RING_OFF + F.wave * 16384);
    const int gw = F.vcu * NWAVES + F.wave, NGW = F.G * NWAVES;
    constexpr int I_IN = (D / 64) * (PROJ / 32), I_OUT = (D / 64) * (D / 32), I_G = I_OUT, I_PLE = (PLE / 64) * (D / 32);
    constexpr int NITEMS = I_IN + I_OUT + I_G + I_PLE;
    for (int it = gw; it < NITEMS; it += NGW) {
        int r = it;
        if (r < I_IN) { p0_transpose_item(F.w_in, D, PROJ, F.WinT, nullptr, scr, r, F.lane, true); continue; } r -= I_IN;
        if (r < I_OUT) { p0_transpose_item(F.w_out, D, D, F.WoutT, nullptr, scr, r, F.lane); continue; } r -= I_OUT;
        if (r < I_G) { p0_transpose_item(F.w_gate, D, D, F.WgT, F.g_ple, scr, r, F.lane); continue; } r -= I_G;
        p0_transpose_item(F.w_ple, PLE, D, F.WpleT, nullptr, scr, r, F.lane);
    }
    if (F.vcu == 0 && F.tid < 256) F.CNT[64 * F.tid] = 0u;
    { const int gt = F.vcu * (NWAVES * 64) + F.tid;
      if (gt < SEQ * 8) { const int pos = gt >> 3, j = gt & 7;
        const double inv = (j == 0) ? 0.15915494309189535 : (j == 1) ? 0.03086376340470123 : (j == 2) ? 0.005985185712713705 : (j == 3) ? 0.001160663641240061 : (j == 4) ? 0.00022507907903927653 : (j == 5) ? 4.364795279280289e-05 : (j == 6) ? 8.464330808241401e-06 : 1.6414262627950345e-06;
        double rev = (double)pos * inv; rev -= __builtin_rint(rev); const float rf = (float)rev;
        F.ROPE[pos * 16 + j] = __builtin_amdgcn_cosf(rf); F.ROPE[pos * 16 + 8 + j] = __builtin_amdgcn_sinf(rf); } }
    { f32x4 g[4];
#pragma unroll
      for (int j = 0; j < 4; ++j) g[j] = ((const GAS f32x4*)F.g_mix)[F.lane + 64 * j];
      for (int m0 = gw * 4; m0 < M; m0 += NGW * 4) {
        f32x4 v[4][4]; float s2[4];
#pragma unroll
        for (int r = 0; r < 4; ++r) { const GAS f32x4* xr = (const GAS f32x4*)(F.x + (size_t)(m0 + r) * D) + F.lane;
#pragma unroll
          for (int j = 0; j < 4; ++j) v[r][j] = __builtin_nontemporal_load(xr + 64 * j); }
#pragma unroll
        for (int r = 0; r < 4; ++r) { s2[r] = 0.f;
#pragma unroll
          for (int j = 0; j < 4; ++j) s2[r] += (v[r][j].x * v[r][j].x + v[r][j].y * v[r][j].y) + (v[r][j].z * v[r][j].z + v[r][j].w * v[r][j].w); }
#pragma unroll
        for (int o = 1; o < 64; o <<= 1) {
#pragma unroll
          for (int r = 0; r < 4; ++r) s2[r] += __shfl_xor(s2[r], o); }
#pragma unroll
        for (int r = 0; r < 4; ++r) { const float rs = 1.f / sqrtf(s2[r] * (1.f / D) + EPS);
          GAS unsigned long long* o8 = (GAS unsigned long long*)(F.XN + (size_t)(m0 + r) * D) + F.lane;
#pragma unroll
          for (int j = 0; j < 4; ++j) { const f32x4 w = v[r][j] * rs * g[j]; o8[64 * j] = (unsigned long long)pk2(w.x, w.y) | ((unsigned long long)pk2(w.z, w.w) << 32); } } } }
    { const size_t nthr = (size_t)F.G * NWAVES * 64; const size_t n8 = (size_t)M * PLE / 8;
      for (size_t i = (size_t)F.vcu * (NWAVES * 64) + F.tid; i < n8; i += nthr) { const f32x4 a = ((const GAS f32x4*)F.p)[2 * i], b = ((const GAS f32x4*)F.p)[2 * i + 1];
        v4u o; o.x = pk2(a.x, a.y); o.y = pk2(a.z, a.w); o.z = pk2(b.x, b.y); o.w = pk2(b.z, b.w); ((GAS v4u*)F.PB)[i] = o; } }
}
__device__ __forceinline__ void final_phase(Frame& F) {
    const int gw = F.vcu * NWAVES + F.wave, NGW = F.G * NWAVES;
    f32x4 g[4];
#pragma unroll
    for (int j = 0; j < 4; ++j) g[j] = ((const GAS f32x4*)F.g_final)[F.lane + 64 * j];
    for (int m0 = gw * 4; m0 < M; m0 += NGW * 4) {
        f32x4 v[4][4]; float s2[4];
#pragma unroll
        for (int r = 0; r < 4; ++r) { const GAS f32x4* xr = (const GAS f32x4*)(F.out + (size_t)(m0 + r) * D) + F.lane;
#pragma unroll
          for (int j = 0; j < 4; ++j) v[r][j] = xr[64 * j]; }
#pragma unroll
        for (int r = 0; r < 4; ++r) { s2[r] = 0.f;
#pragma unroll
          for (int j = 0; j < 4; ++j) s2[r] += (v[r][j].x * v[r][j].x + v[r][j].y * v[r][j].y) + (v[r][j].z * v[r][j].z + v[r][j].w * v[r][j].w); }
#pragma unroll
        for (int o = 1; o < 64; o <<= 1) {
#pragma unroll
          for (int r = 0; r < 4; ++r) s2[r] += __shfl_xor(s2[r], o); }
#pragma unroll
        for (int r = 0; r < 4; ++r) { const float rs = 1.f / sqrtf(s2[r] * (1.f / D) + EPS);
          GAS f32x4* xw = (GAS f32x4*)(F.out + (size_t)(m0 + r) * D) + F.lane;
#pragma unroll
          for (int j = 0; j < 4; ++j) __builtin_nontemporal_store(v[r][j] * rs * g[j], xw + 64 * j); }
    }
}

struct Args { const float* in[14]; float* out; unsigned char* ws; int ph_lo, ph_hi, cgsync, pad; };
__global__ void __launch_bounds__(NWAVES * 64, 2) mk_fwd(Args args) {
    extern __shared__ __attribute__((aligned(16))) unsigned char lds[];
    Frame F;
    F.lds = (LAS unsigned char*)lds;
    F.tid = threadIdx.x; F.lane = F.tid & 63; F.wave = __builtin_amdgcn_readfirstlane(F.tid >> 6);
    F.G = gridDim.x; { const int bx = blockIdx.x; F.vcu = (F.G % 8 == 0) ? (bx % 8) * (F.G / 8) + bx / 8 : bx; }
    unsigned char* ws = args.ws;
    F.x = args.in[0]; F.p = args.in[1]; F.w_in = args.in[2]; F.w_out = args.in[3]; F.g_mix = args.in[4]; F.lq1 = args.in[5]; F.lk1 = args.in[6]; F.lq2 = args.in[7]; F.lk2 = args.in[8];
    F.g_subln = args.in[9]; F.w_ple = args.in[10]; F.w_gate = args.in[11]; F.g_ple = args.in[12]; F.g_final = args.in[13]; F.out = args.out;
    F.WinT = (bf16*)(ws + WS_WIN); F.WoutT = (bf16*)(ws + WS_WOUT); F.WgT = (bf16*)(ws + WS_WG); F.WpleT = (bf16*)(ws + WS_WPLE);
    F.PROJB = (bf16*)(ws + WS_PROJ); F.ZB = (bf16*)(ws + WS_Z); F.HB = (bf16*)(ws + WS_HB); F.PE = (bf16*)(ws + WS_PE); F.XN = (bf16*)(ws + WS_XN); F.OM = (bf16*)(ws + WS_OM); F.OD = (bf16*)(ws + WS_OD); F.PB = (bf16*)(ws + WS_PB);
    F.ROPE = (float*)(ws + WS_ROPE); F.KMEAN = (float*)(ws + WS_KMEAN); F.PART = (float*)(ws + WS_PART); F.PART2 = (float*)(ws + WS_PART2); F.CNT = (unsigned*)(ws + WS_CNT);
    const int lo = args.ph_lo, hi = args.ph_hi;
    volatile LAS unsigned* MISC = (volatile LAS unsigned*)(F.lds + RING_BYTES + 320);
    if (F.tid < 32) MISC[F.tid] = 0u;
    __syncthreads();
    XcdBarrier bar = xcd_barrier_post((unsigned*)ws, MISC + 8, F.tid);
#ifndef REP_PHASE
#define REP_PHASE -1
#endif
#define NREP(k) (((k) == REP_PHASE) ? 2 : 1)
#ifndef PHMASK
#define PHMASK 0xff
#endif
#define IN(k) (((PHMASK >> (k)) & 1) && lo <= (k) && (k) < hi)
#define GRIDBAR() do { if (args.cgsync) cg::this_grid().sync(); else xcd_barrier(bar, tid_now(F.wave)); } while (0)
#define SEAM3B do { if (IN(3) && IN(5)) { GRIDBAR(); } } while (0)
#define SEAM(k) do { if (IN(k) && IN((k) + 1)) { GRIDBAR(); } } while (0)

    if (IN(0)) { for (int rp = 0; rp < NREP(0); ++rp) p0_prologue(F); }
    SEAM(0);
    if (IN(1)) {
        pg8::Gemm g{F.XN, F.WinT, M, PROJ, D}; pg8::StaticOrder S; S.init(M, PROJ, F.G, (int)blockIdx.x);
        pg8::EpiProj E{F.PROJB, F.ZB, F.ROPE, F.KMEAN};
        pg8::gemm_phase<pg8::EpiProj, pg8::StaticOrder, PG8_ALIGN, PG8_SP2>(F.lds + RING_OFF, g, S, E, F.wave);
    }
    if (IN(1) && NREP(1) == 2) {
        pg8::Gemm g{F.XN, F.WinT, M, PROJ, D}; pg8::StaticOrder S; S.init(M, PROJ, F.G, (int)blockIdx.x);
        pg8::EpiProj E{F.PROJB, F.ZB, F.ROPE, F.KMEAN};
        pg8::gemm_phase<pg8::EpiProj, pg8::StaticOrder, PG8_ALIGN, PG8_SP2>(F.lds + RING_OFF, g, S, E, F.wave);
    }
    if (IN(1) && IN(3)) { GRIDBAR(); }
    if (IN(3)) for (int rp = 0; rp < NREP(3); ++rp) {
        const attn_body::AttnArgs AT{(const attn_body::bf16*)F.PROJB, (const attn_body::bf16*)F.ZB, (attn_body::bf16*)F.XN, (attn_body::bf16*)F.OD, F.KMEAN, F.g_subln, F.lq1, F.lk1, F.lq2, F.lk2};
        attn_body::attn_phase<8>((char*)lds + RING_OFF, AT, F.vcu, F.G, F.wave);
    }
    SEAM3B;
    if (IN(5)) {
        { pg8::Gemm g{F.XN, F.WoutT, M, D, D}; pg8::StaticOrder S; S.init(M, D, F.G, (int)blockIdx.x);
          pg8::EpiOut E{F.x, F.HB, F.PART};
          pg8::gemm_phase<pg8::EpiOut, pg8::StaticOrder, PG8_ALIGN, PG8_SP2>(F.lds + RING_OFF, g, S, E, F.wave); }
        { int kple = PLE; asm volatile("" : "+s"(kple));
          pg8::Gemm g{F.PB, F.WpleT, M, D, kple}; pg8::StaticOrder S; S.init(M, D, F.G, (int)blockIdx.x);
          pg8::EpiBf16<0> E{F.PE, D, nullptr, 0, 0, 1.f};
          pg8::gemm_phase<pg8::EpiBf16<0>, pg8::StaticOrder, PG8_ALIGN, PG8_SP2>(F.lds + RING_OFF, g, S, E, F.wave); }
    }
    if (IN(5) && NREP(5) == 2) {
        { pg8::Gemm g{F.XN, F.WoutT, M, D, D}; pg8::StaticOrder S; S.init(M, D, F.G, (int)blockIdx.x);
          pg8::EpiOut E{F.x, F.HB, F.PART};
          pg8::gemm_phase<pg8::EpiOut, pg8::StaticOrder, PG8_ALIGN, PG8_SP2>(F.lds + RING_OFF, g, S, E, F.wave); }
        { int kple = PLE; asm volatile("" : "+s"(kple));
          pg8::Gemm g{F.PB, F.WpleT, M, D, kple}; pg8::StaticOrder S; S.init(M, D, F.G, (int)blockIdx.x);
          pg8::EpiBf16<0> E{F.PE, D, nullptr, 0, 0, 1.f};
          pg8::gemm_phase<pg8::EpiBf16<0>, pg8::StaticOrder, PG8_ALIGN, PG8_SP2>(F.lds + RING_OFF, g, S, E, F.wave); }
    }
    SEAM(5);
    if (IN(6)) {
        pg8::Gemm g{F.HB, F.WgT, M, D, D}; pg8::StaticOrder S; S.init(M, D, F.G, (int)blockIdx.x);
        pg8::EpiGate E{F.HB, F.PE, F.out, F.PART, F.PART2, F.CNT, F.g_final};
        pg8::gemm_phase<pg8::EpiGate, pg8::StaticOrder, PG8_ALIGN, PG8_SP2>(F.lds + RING_OFF, g, S, E, F.wave);
    }
#undef IN
#undef SEAM
}

extern "C" void kernel_launch(void* const* d_in, const int* in_sizes, int n_in, void* d_out, int out_size, void* d_ws, size_t ws_size, hipStream_t stream) {
    static int grid = 0;
    if (grid == 0) {
        if (n_in != 14 || in_sizes[0] != M * D || out_size != M * D || ws_size < WS_END) { fprintf(stderr, "kernel_launch: shape/workspace mismatch: n_in %d, in0 %d, out %d, ws %zu (need %zu)\n", n_in, n_in > 0 ? in_sizes[0] : -1, out_size, ws_size, (size_t)WS_END); grid = -1; return; }
        int dev = 0, cus = 0, per_cu = 0;
        if (hipGetDevice(&dev) != hipSuccess || hipDeviceGetAttribute(&cus, hipDeviceAttributeMultiprocessorCount, dev) != hipSuccess) { fprintf(stderr, "kernel_launch: device query failed\n"); grid = -1; return; }
        if (hipFuncSetAttribute((const void*)mk_fwd, hipFuncAttributeMaxDynamicSharedMemorySize, LDS_BYTES) != hipSuccess) { fprintf(stderr, "kernel_launch: hipFuncSetAttribute failed\n"); grid = -1; return; }
        if (hipOccupancyMaxActiveBlocksPerMultiprocessor(&per_cu, (const void*)mk_fwd, NWAVES * 64, LDS_BYTES) != hipSuccess || per_cu < 1) { fprintf(stderr, "kernel_launch: occupancy query reports %d\n", per_cu); per_cu = 1; }
        (void)hipGetLastError();
        grid = cus;
    }
    if (grid < 0) return;
    if (hipMemsetAsync(d_ws, 0, 65536, stream) != hipSuccess) { fprintf(stderr, "kernel_launch: hipMemsetAsync failed\n"); return; }
    Args a{};
    for (int i = 0; i < 14; ++i) a.in[i] = (const float*)d_in[i];
    a.out = (float*)d_out; a.ws = (unsigned char*)d_ws;
    if (N_LAUNCHES == 1) {
        a.ph_lo = 0; a.ph_hi = N_PHASES;
        void* kargs[] = {&a};
        const hipError_t le = hipLaunchCooperativeKernel((const void*)mk_fwd, dim3(grid), dim3(NWAVES * 64), kargs, LDS_BYTES, stream);
        if (le != hipSuccess) fprintf(stderr, "kernel_launch: cooperative launch failed: %s (grid %d)\n", hipGetErrorString(le), grid);
    } else {
        for (int li = 0; li < N_PHASES; ++li) {
            a.ph_lo = li; a.ph_hi = li + 1;
            hipLaunchKernelGGL(mk_fwd, dim3(grid), dim3(NWAVES * 64), LDS_BYTES, stream, a);
            const hipError_t le = hipPeekAtLastError();
            if (le != hipSuccess) { fprintf(stderr, "kernel_launch: launch %d failed: %s\n", li, hipGetErrorName(le)); break; }
        }
    }
}
```

```cpp
#include <hip/hip_runtime.h>
#include <hip/hip_cooperative_groups.h>
#include <cstdio>
#include <cstdint>
namespace cg = cooperative_groups;
__device__ __forceinline__ int tid_now(int wave_s) { unsigned z = 0u; asm volatile("" : "+s"(z)); return wave_s * 64 + (int)__builtin_amdgcn_mbcnt_hi(~0u, __builtin_amdgcn_mbcnt_lo(~0u, z)); }
namespace pg8 {
#define PG8_LAS __attribute__((address_space(3)))
typedef unsigned short bf16_t;
typedef short bf16x8 __attribute__((ext_vector_type(8)));
typedef float f32x4 __attribute__((ext_vector_type(4)));
typedef unsigned u32x4 __attribute__((ext_vector_type(4)));
constexpr int BM = 256, BK = 64, HALF = 128, HTB = HALF * BK * 2  , STAGE_BYTES = 8 * HTB, NXCD = 8, WGM = 8;

__host__ __device__ __forceinline__ int lds_byte(int r, int c) { const int st = (r >> 4) * 2 + (c >> 5), rr = r & 15, cc = c & 31, ob = rr * 64 + cc * 2; return st * 1024 + (ob ^ (((ob >> 9) & 1) << 5)); }
__host__ __device__ __forceinline__ void stage_rc(int b, int& R, int& C) { const int st = b / 1024, sb = b % 1024, swz = sb ^ (((sb >> 9) & 1) << 5); R = (st >> 1) * 16 + swz / 64; C = (st & 1) * 32 + (swz % 64) / 2; }
__host__ __device__ __forceinline__ int perm32(int rho) { const int n = rho >> 4, i = rho & 15; return 8 * (i >> 2) + 4 * n + (i & 3); }

struct Unit { int pm, pn; };
struct Gemm { const bf16_t* A; const bf16_t* Bt; int M, N, K; };

struct StaticOrder {
    int nM, nN, nwg, G, c;
    __host__ __device__ void init(int M, int N, int G_, int c_) { nM = M / BM; nN = N / BM; nwg = nM * nN; G = G_; c = c_; }
    __host__ __device__ bool next(int i, Unit& u) const {
        const long L = (long)i * G + c; if (L >= nwg) return false;
        int wgid = (int)L; { const int q = nwg / NXCD, r = nwg % NXCD, xcd = wgid % NXCD, off = wgid / NXCD; wgid = (xcd < r ? xcd * (q + 1) : r * (q + 1) + (xcd - r) * q) + off; }
        const int nig = WGM * nN, gid = wgid / nig, fm = gid * WGM, gsz = (nM - fm) < WGM ? (nM - fm) : WGM;
        u.pm = fm + ((wgid % nig) % gsz); u.pn = (wgid % nig) / gsz; return true;
    }
    __device__ __forceinline__ void a_ready(const Unit&) const {}
    __device__ __forceinline__ void done(const Unit&) const {}
};

__device__ __forceinline__ unsigned cvt_pk_bf16(float lo, float hi) { unsigned r; asm volatile("v_cvt_pk_bf16_f32 %0, %1, %2" : "=v"(r) : "v"(lo), "v"(hi)); return r; }
typedef float f32x2 __attribute__((ext_vector_type(2)));
__device__ __forceinline__ f32x2 gelu_pk(f32x2 v) {
    const f32x2 av = __builtin_elementwise_abs(v), d = av * 0.2316418882f + 1.0f;
    f32x2 t; t.x = __builtin_amdgcn_rcpf(d.x); t.y = __builtin_amdgcn_rcpf(d.y);
    f32x2 q = t * 0.5307027145f + (-0.7265760135f); q = q * t + 0.7107068705f; q = q * t + (-0.142248368f); q = q * t + 0.127414796f; q = q * t;
    const f32x2 s = (v * v) * (-0.72134752044f);
    f32x2 e; e.x = __builtin_amdgcn_exp2f(s.x); e.y = __builtin_amdgcn_exp2f(s.y);
    const f32x2 m = v * (q * e), r = v - m;
    f32x2 o; o.x = v.x < 0.f ? m.x : r.x; o.y = v.y < 0.f ? m.y : r.y; return o;
}

template <int ACT  > struct EpiBf16 {
    static constexpr int VMOPS = 16;
    static constexpr bool PERM = true, AFTER_DRAIN = false; static_assert(ACT == 0 || ACT == 1, "EpiBf16: ACT is 0 (none) or 1 (gelu_pk)");
    bf16_t* O; int ldc; const float* bias; int split_cols; size_t split_stride; float scale0;
    __device__ __forceinline__ void operator()(const f32x4 (&acc)[2][2][4][2], const Unit& u, int wr, int wc, int fr, int fq) const {
        const int row0 = u.pm * BM + wr * 64 + fr; int colt = u.pn * BM; bf16_t* base = O;
        float sc = 1.f; if (split_cols) { const int t = colt / split_cols; base += (size_t)t * split_stride; colt -= t * split_cols; if (t == 0) sc = scale0; }
        const int col0 = colt + wc * 32 + 8 * fq, bcol0 = u.pn * BM + wc * 32 + 8 * fq;
        f32x4 bv[2][2];
#pragma unroll
        for (int bj = 0; bj < 2; ++bj)
#pragma unroll
            for (int n = 0; n < 2; ++n) bv[bj][n] = bias ? *(const f32x4*)(bias + bcol0 + bj * HALF + 4 * n) : (f32x4){0.f, 0.f, 0.f, 0.f};
#pragma unroll
        for (int ai = 0; ai < 2; ++ai)
#pragma unroll
            for (int m = 0; m < 4; ++m) { bf16_t* rowp = base + (size_t)(row0 + ai * HALF + m * 16) * ldc + col0;
#pragma unroll
                for (int bj = 0; bj < 2; ++bj) { f32x4 v0 = acc[ai][bj][m][0] + bv[bj][0], v1 = acc[ai][bj][m][1] + bv[bj][1];
                    if (ACT == 1) { f32x2 a = gelu_pk((f32x2){v0[0], v0[1]}), b = gelu_pk((f32x2){v0[2], v0[3]}), c = gelu_pk((f32x2){v1[0], v1[1]}), d = gelu_pk((f32x2){v1[2], v1[3]});
                        v0 = (f32x4){a.x, a.y, b.x, b.y}; v1 = (f32x4){c.x, c.y, d.x, d.y}; }
                    v0 = v0 * sc; v1 = v1 * sc; u32x4 w; w.x = cvt_pk_bf16(v0[0], v0[1]); w.y = cvt_pk_bf16(v0[2], v0[3]); w.z = cvt_pk_bf16(v1[0], v1[1]); w.w = cvt_pk_bf16(v1[2], v1[3]);
                    *(u32x4*)(rowp + bj * HALF) = w; } }
    }
};
constexpr float QC2 = 0.125f * 1.4426950408889634f;
struct EpiProj {
    static constexpr int VMOPS = 16;
    static constexpr bool PERM = true, AFTER_DRAIN = false;
    bf16_t* O; bf16_t* Z; const float* rope; float* kpart;
    __device__ __forceinline__ void operator()(const f32x4 (&acc)[2][2][4][2], const Unit& u, int wr, int wc, int fr, int fq) const {
        const int pn = u.pn;
        const bool do_rope = (pn < 4) || (pn >= 6 && pn < 10);
        const bool is_q = (pn < 2) || (pn == 6) || (pn == 7);
        const bool do_silu = pn >= 12;
        const float sc = is_q ? QC2 : 1.f;
        const int row0 = u.pm * BM + wr * 64 + fr;
        const float sg = (fq == 0) ? -1.f : 1.f;
        const bool is_mk = (pn == 2) || (pn == 3);
        f32x4 cs0 = {0.f, 0.f, 0.f, 0.f}, cs1 = cs0, cs2 = cs0, cs3 = cs0;
#pragma unroll
        for (int ai = 0; ai < 2; ++ai)
#pragma unroll
            for (int m = 0; m < 4; ++m) {
                const int row = row0 + ai * HALF + m * 16;
                bf16_t* rowp = do_silu ? Z + (size_t)row * 1024 + (pn - 12) * 256 + wc * 64 + 8 * fq : O + ((size_t)(pn * 4 + wc) * 65536 + row) * 64 + 8 * fq;
                f32x4 v0 = acc[ai][0][m][0], v1 = acc[ai][0][m][1], w0 = acc[ai][1][m][0], w1 = acc[ai][1][m][1];
                if (do_rope) {
                    f32x4 c0 = {1.f, 1.f, 1.f, 1.f}, c1 = c0, s0 = {0.f, 0.f, 0.f, 0.f}, s1 = s0;
                    if (fq < 2) { const float* rp = rope + (row & 2047) * 16; c0 = *(const f32x4*)(rp); c1 = *(const f32x4*)(rp + 4); s0 = *(const f32x4*)(rp + 8) * sg; s1 = *(const f32x4*)(rp + 12) * sg; }
                    f32x4 p0, p1;
#pragma unroll
                    for (int e = 0; e < 4; ++e) { p0[e] = __shfl_xor(v0[e], 16); p1[e] = __shfl_xor(v1[e], 16); }
                    v0 = v0 * c0 + p0 * s0; v1 = v1 * c1 + p1 * s1;
                }
                if (do_silu) {
#pragma unroll
                    for (int e = 0; e < 4; ++e) { v0[e] = v0[e] * __builtin_amdgcn_rcpf(1.f + __expf(-v0[e])); v1[e] = v1[e] * __builtin_amdgcn_rcpf(1.f + __expf(-v1[e]));
                                                  w0[e] = w0[e] * __builtin_amdgcn_rcpf(1.f + __expf(-w0[e])); w1[e] = w1[e] * __builtin_amdgcn_rcpf(1.f + __expf(-w1[e])); }
                }
                if (is_mk) { cs0 += v0; cs1 += v1; cs2 += w0; cs3 += w1; }
                v0 = v0 * sc; v1 = v1 * sc; w0 = w0 * sc; w1 = w1 * sc;
                u32x4 a, b; a.x = cvt_pk_bf16(v0[0], v0[1]); a.y = cvt_pk_bf16(v0[2], v0[3]); a.z = cvt_pk_bf16(v1[0], v1[1]); a.w = cvt_pk_bf16(v1[2], v1[3]);
                b.x = cvt_pk_bf16(w0[0], w0[1]); b.y = cvt_pk_bf16(w0[2], w0[3]); b.z = cvt_pk_bf16(w1[0], w1[1]); b.w = cvt_pk_bf16(w1[2], w1[3]);
                __builtin_nontemporal_store(a, (u32x4*)(rowp)); __builtin_nontemporal_store(b, (u32x4*)(rowp + 32));
            }
        if (is_mk) {
#pragma unroll
            for (int e = 0; e < 4; ++e) {
#pragma unroll
                for (int o = 1; o < 16; o <<= 1) { cs0[e] += __shfl_xor(cs0[e], o); cs1[e] += __shfl_xor(cs1[e], o); cs2[e] += __shfl_xor(cs2[e], o); cs3[e] += __shfl_xor(cs3[e], o); } }
            if (fr == 0) { float* kp = kpart + ((size_t)u.pm * 2 + wr) * 512 + (pn - 2) * 256 + wc * 64 + 8 * fq;
                *(f32x4*)(kp) = cs0; *(f32x4*)(kp + 4) = cs1; *(f32x4*)(kp + 32) = cs2; *(f32x4*)(kp + 36) = cs3; }
        }
    }
};
typedef unsigned u32x2 __attribute__((ext_vector_type(2)));
struct EpiOut {
    static constexpr int VMOPS = 32;
    static constexpr bool PERM = false, AFTER_DRAIN = false;
    const float* x; bf16_t* hb; float* part;
    __device__ __forceinline__ void operator()(const f32x4 (&acc)[2][2][4][2], const Unit& u, int wr, int wc, int fr, int fq) const {
        const int col0 = u.pn * BM + wc * 32 + 4 * fq;
#pragma unroll
        for (int ai = 0; ai < 2; ++ai) {
            f32x4 xv[4][2][2];
#pragma unroll
            for (int m = 0; m < 4; ++m) { const size_t off = (size_t)(u.pm * BM + ai * HALF + wr * 64 + m * 16 + fr) * 1024 + col0;
#pragma unroll
                for (int bj = 0; bj < 2; ++bj)
#pragma unroll
                    for (int n = 0; n < 2; ++n) xv[m][bj][n] = __builtin_nontemporal_load((const f32x4*)(x + off + bj * HALF + n * 16)); }
#pragma unroll
            for (int m = 0; m < 4; ++m) {
                const int r = u.pm * BM + ai * HALF + wr * 64 + m * 16 + fr; const size_t off = (size_t)r * 1024 + col0; float ss = 0.f;
#pragma unroll
                for (int bj = 0; bj < 2; ++bj)
#pragma unroll
                    for (int n = 0; n < 2; ++n) {
                        const f32x4 h = xv[m][bj][n] + acc[ai][bj][m][n];
                        ss += (h[0] * h[0] + h[1] * h[1]) + (h[2] * h[2] + h[3] * h[3]);
                        u32x2 w; w.x = cvt_pk_bf16(h[0], h[1]); w.y = cvt_pk_bf16(h[2], h[3]);
                        *(u32x2*)(hb + off + bj * HALF + n * 16) = w;
                    }
                ss += __shfl_xor(ss, 16); ss += __shfl_xor(ss, 32);
                if (fq == 0) part[(size_t)r * 16 + u.pn * 4 + wc] = ss;
            }
            asm volatile("" ::: "memory");
        }
    }
};
struct EpiGate {
    static constexpr int VMOPS = 32;
    static constexpr bool PERM = false, AFTER_DRAIN = false;
    const bf16_t* hb; const bf16_t* pe; float* out; const float* part; float* part2; unsigned* cnt; const float* gfin;
    __device__ __forceinline__ void operator()(f32x4 (&acc)[2][2][4][2], const Unit& u, int wr, int wc, int fr, int fq) const {
        const int col0 = u.pn * BM + wc * 32 + 4 * fq;
        const int rbase = u.pm * BM + wr * 64 + fr;
        float rs[8];
        { f32x4 q[8];
#pragma unroll
          for (int k = 0; k < 8; ++k) q[k] = *(const f32x4*)(part + (size_t)(rbase + (k >> 2) * HALF + (k & 3) * 16) * 16 + 4 * fq);
#pragma unroll
          for (int k = 0; k < 8; ++k) { float t = (q[k][0] + q[k][1]) + (q[k][2] + q[k][3]); t += __shfl_xor(t, 16); t += __shfl_xor(t, 32); rs[k] = __builtin_amdgcn_rsqf(t * (1.f / 1024.f) + 1e-6f); } }
#pragma unroll
        for (int kp = 0; kp < 4; ++kp) { const int ai = kp >> 1;
            u32x2 hv[2][2][2], pv[2][2][2];
#pragma unroll
            for (int mm = 0; mm < 2; ++mm) { const int m = (kp & 1) * 2 + mm; const size_t off = (size_t)(rbase + ai * HALF + m * 16) * 1024 + col0;
#pragma unroll
                for (int bj = 0; bj < 2; ++bj)
#pragma unroll
                    for (int n = 0; n < 2; ++n) { hv[mm][bj][n] = *(const u32x2*)(hb + off + bj * HALF + n * 16); pv[mm][bj][n] = *(const u32x2*)(pe + off + bj * HALF + n * 16); } }
#pragma unroll
            for (int mm = 0; mm < 2; ++mm) { const int m = (kp & 1) * 2 + mm;
#pragma unroll
                for (int bj = 0; bj < 2; ++bj)
#pragma unroll
                    for (int n = 0; n < 2; ++n) {
                        const u32x2 hw = hv[mm][bj][n], pw = pv[mm][bj][n];
                        const f32x4 h = {__uint_as_float(hw.x << 16), __uint_as_float(hw.x & 0xffff0000u), __uint_as_float(hw.y << 16), __uint_as_float(hw.y & 0xffff0000u)};
                        const f32x4 p = {__uint_as_float(pw.x << 16), __uint_as_float(pw.x & 0xffff0000u), __uint_as_float(pw.y << 16), __uint_as_float(pw.y & 0xffff0000u)};
                        const f32x4 a = acc[ai][bj][m][n] * rs[ai * 4 + m]; f32x4 o;
#pragma unroll
                        for (int e = 0; e < 4; ++e) o[e] = h[e] + p[e] * __builtin_amdgcn_rcpf(1.f + __expf(-a[e]));
                        acc[ai][bj][m][n] = o;
                    } }
            asm volatile("" ::: "memory");
        }
        { float ssv[8];
#pragma unroll
          for (int k = 0; k < 8; ++k) { const int ai = k >> 2, m = k & 3; float ss = 0.f;
#pragma unroll
            for (int bj = 0; bj < 2; ++bj)
#pragma unroll
                for (int n = 0; n < 2; ++n) { const f32x4 h = acc[ai][bj][m][n]; ss += (h[0] * h[0] + h[1] * h[1]) + (h[2] * h[2] + h[3] * h[3]); }
            ss += __shfl_xor(ss, 16); ss += __shfl_xor(ss, 32); ssv[k] = ss; }
          if (fq == 0) {
#pragma unroll
            for (int k = 0; k < 8; ++k) __hip_atomic_store(part2 + (size_t)(rbase + (k >> 2) * HALF + (k & 3) * 16) * 16 + u.pn * 4 + wc, ssv[k], __ATOMIC_RELAXED, __HIP_MEMORY_SCOPE_AGENT); } }
        asm volatile("s_waitcnt vmcnt(0)" ::: "memory");
        unsigned* c = cnt + 64 * u.pm;
        if (fr == 0 && fq == 0) __hip_atomic_fetch_add(c, 1u, __ATOMIC_RELAXED, __HIP_MEMORY_SCOPE_AGENT);
        { unsigned sp = 0;
          while ((unsigned)__builtin_amdgcn_readfirstlane(__hip_atomic_load(c, __ATOMIC_RELAXED, __HIP_MEMORY_SCOPE_AGENT)) < 32u) { __builtin_amdgcn_s_sleep(8); if (++sp > (1u << 20)) break; } }
#pragma unroll
        for (int k = 0; k < 8; ++k) { const float* pp = part2 + (size_t)(rbase + (k >> 2) * HALF + (k & 3) * 16) * 16 + 4 * fq;
            const float t0 = __hip_atomic_load(pp, __ATOMIC_RELAXED, __HIP_MEMORY_SCOPE_AGENT), t1 = __hip_atomic_load(pp + 1, __ATOMIC_RELAXED, __HIP_MEMORY_SCOPE_AGENT),
                        t2 = __hip_atomic_load(pp + 2, __ATOMIC_RELAXED, __HIP_MEMORY_SCOPE_AGENT), t3 = __hip_atomic_load(pp + 3, __ATOMIC_RELAXED, __HIP_MEMORY_SCOPE_AGENT);
            float t = (t0 + t1) + (t2 + t3); t += __shfl_xor(t, 16); t += __shfl_xor(t, 32); rs[k] = __builtin_amdgcn_rsqf(t * (1.f / 1024.f) + 1e-6f); }
        f32x4 gf[2][2];
#pragma unroll
        for (int bj = 0; bj < 2; ++bj)
#pragma unroll
            for (int n = 0; n < 2; ++n) gf[bj][n] = *(const f32x4*)(gfin + col0 + bj * HALF + n * 16);
#pragma unroll
        for (int k = 0; k < 8; ++k) { const int ai = k >> 2, m = k & 3; const size_t off = (size_t)(rbase + ai * HALF + m * 16) * 1024 + col0;
#pragma unroll
            for (int bj = 0; bj < 2; ++bj)
#pragma unroll
                for (int n = 0; n < 2; ++n) __builtin_nontemporal_store(acc[ai][bj][m][n] * rs[k] * gf[bj][n], (f32x4*)(out + off + bj * HALF + n * 16)); }
    }
};

template <class Epi, class Sched, bool ALIGN_EPI = false, bool SP2 = false>
__device__ __forceinline__ void gemm_phase(PG8_LAS unsigned char* lds, const Gemm g, const Sched& S, const Epi& E, const int wave_s) {
    const int tid = tid_now(wave_s), wid = __builtin_amdgcn_readfirstlane(tid >> 6), lane = tid & 63, wr = wid >> 2, wc = wid & 3, fr = lane & 15, fq = lane >> 4;
    const int K = g.K, nt = K / BK;
    unsigned voffA[2], voffB[2];
#pragma unroll
    for (int i = 0; i < 2; ++i) { int R, C; stage_rc(tid * 16 + i * 8192, R, C); const int Rb = Epi::PERM ? ((R & ~31) + perm32(R & 31)) : R;
        voffA[i] = (unsigned)(R * K + C) * 2u; voffB[i] = (unsigned)(Rb * K + C) * 2u; }
    const size_t kstep = (size_t)(BK * 2);
    const size_t hstep = (size_t)HALF * K * 2;
    const size_t tstep = 2 * hstep;
    const unsigned ldsw = (unsigned)wid * 1024u;
    const int aoff = lds_byte(wr * 64 + fr, fq * 8), boff = lds_byte(wc * 32 + fr, fq * 8);
#define PG8_SA(b, h) (((b) * 2 + (h)) * HTB)
#define PG8_SB(b, h) ((4 + (b) * 2 + (h)) * HTB)
#define PG8_STAGE(bufoff, gbase, voff) do { _Pragma("unroll") for (int _i = 0; _i < 2; ++_i) \
        __builtin_amdgcn_global_load_lds((const unsigned*)((const char*)(gbase) + (voff)[_i]), (PG8_LAS unsigned*)(lds + (bufoff) + ldsw + _i * 8192), 16, 0, 0); } while (0)
#define PG8_LDA(dst, b, h) do { _Pragma("unroll") for (int m = 0; m < 4; ++m) _Pragma("unroll") for (int k = 0; k < 2; ++k) dst[m][k] = *(const PG8_LAS bf16x8*)(lds + PG8_SA(b, h) + aoff + m * 2048 + k * 1024); } while (0)
#define PG8_LDB(dst, b, h) do { _Pragma("unroll") for (int n = 0; n < 2; ++n) _Pragma("unroll") for (int k = 0; k < 2; ++k) dst[n][k] = *(const PG8_LAS bf16x8*)(lds + PG8_SB(b, h) + boff + n * 2048 + k * 1024); } while (0)
#define PG8_MMA(ai, bj, At, Bt) do { __builtin_amdgcn_s_setprio(1); _Pragma("unroll") for (int m = 0; m < 4; ++m) _Pragma("unroll") for (int n = 0; n < 2; ++n) _Pragma("unroll") for (int k = 0; k < 2; ++k) \
        acc[ai][bj][m][n] = __builtin_amdgcn_mfma_f32_16x16x32_bf16(Bt[n][k], At[m][k], acc[ai][bj][m][n], 0, 0, 0); __builtin_amdgcn_s_setprio(0); } while (0)
#define PG8_WAIT_V(n) asm volatile("s_waitcnt vmcnt(" #n ")" ::: "memory")
#define PG8_WAIT_V8_OR(flag, big) asm volatile("s_cmp_eq_u32 %0, 0\n\ts_cbranch_scc1 .Lpg8w8_%=\n\ts_waitcnt vmcnt(%1)\n\ts_branch .Lpg8wd_%=\n.Lpg8w8_%=:\n\ts_waitcnt vmcnt(8)\n.Lpg8wd_%=:" :: "s"(flag), "n"(big) : "memory", "scc")
#define PG8_WAIT_L(n) asm volatile("s_waitcnt lgkmcnt(" #n ")" ::: "memory")
#define PG8_BAR __builtin_amdgcn_s_barrier()
#define PG8_SCHED __builtin_amdgcn_sched_barrier(0)
    Unit cur, nxt; int ui = 0;
    if (!S.next(0, cur)) return;
    f32x4 acc[2][2][4][2];
#pragma unroll
    for (int a = 0; a < 2; ++a)
#pragma unroll
        for (int b = 0; b < 2; ++b)
#pragma unroll
            for (int m = 0; m < 4; ++m)
#pragma unroll
                for (int n = 0; n < 2; ++n) acc[a][b][m][n] = (f32x4){0.f, 0.f, 0.f, 0.f};
    bf16x8 At[4][2], B0[2][2], B1[2][2];
    const char* cA = (const char*)g.A + (size_t)cur.pm * tstep; const char* cB = (const char*)g.Bt + (size_t)cur.pn * tstep;
    S.a_ready(cur);
    if constexpr (SP2) {
        PG8_STAGE(PG8_SB(0, 0), cB, voffB); PG8_STAGE(PG8_SB(0, 1), cB + hstep, voffB); PG8_STAGE(PG8_SA(0, 0), cA, voffA); PG8_STAGE(PG8_SA(0, 1), cA + hstep, voffA);
        if (wr == 1) PG8_BAR;
        PG8_WAIT_V(2); PG8_BAR;
        PG8_STAGE(PG8_SB(1, 0), cB + kstep, voffB); PG8_STAGE(PG8_SA(1, 0), cA + kstep, voffA); PG8_STAGE(PG8_SB(1, 1), cB + hstep + kstep, voffB);
        PG8_WAIT_V(6); PG8_BAR;
    } else {
        PG8_STAGE(PG8_SB(0, 0), cB, voffB); PG8_STAGE(PG8_SA(0, 0), cA, voffA); PG8_STAGE(PG8_SB(0, 1), cB + hstep, voffB); PG8_STAGE(PG8_SA(0, 1), cA + hstep, voffA);
        if (wr == 1) PG8_BAR;
        PG8_WAIT_V(4); PG8_BAR;
        PG8_STAGE(PG8_SB(1, 0), cB + kstep, voffB); PG8_STAGE(PG8_SA(1, 0), cA + kstep, voffA); PG8_STAGE(PG8_SB(1, 1), cB + hstep + kstep, voffB);
        PG8_WAIT_V(6); PG8_BAR;
    }
    for (;;) {
        const bool has_next = S.next(ui + 1, nxt);
        const char* nA = has_next ? (const char*)g.A + (size_t)nxt.pm * tstep : cA; const char* nB = has_next ? (const char*)g.Bt + (size_t)nxt.pn * tstep : cB;
        for (int t = 0; t < nt; t += 2) {
            const bool last = (t == nt - 2);
            const char* a1 = cA + (size_t)(t + 1) * kstep;
            const char* a2 = last ? nA : cA + (size_t)(t + 2) * kstep; const char* b2 = last ? nB : cB + (size_t)(t + 2) * kstep;
            const char* a3 = a2 + kstep; const char* b3 = b2 + kstep;
            if (last && has_next) S.a_ready(nxt);
            if constexpr (SP2) {
            const int relax = __builtin_amdgcn_readfirstlane((t == 0 && ui > 0 && Epi::VMOPS > 0) ? 1 : 0);
            PG8_LDB(B0, 0, 0); PG8_LDB(B1, 0, 1); PG8_SCHED; PG8_LDA(At, 0, 0); PG8_STAGE(PG8_SA(1, 1), a1 + hstep, voffA);
            PG8_WAIT_V8_OR(relax, 8 + Epi::VMOPS); PG8_WAIT_L(0); PG8_BAR; PG8_MMA(0, 0, At, B0); PG8_MMA(0, 1, At, B1); PG8_BAR; PG8_SCHED;
            PG8_LDA(At, 0, 1); PG8_STAGE(PG8_SB(0, 0), b2, voffB); PG8_STAGE(PG8_SB(0, 1), b2 + hstep, voffB); PG8_STAGE(PG8_SA(0, 0), a2, voffA);
            PG8_WAIT_V8_OR(relax, 8 + Epi::VMOPS); PG8_WAIT_L(0); PG8_BAR; PG8_MMA(1, 0, At, B0); PG8_MMA(1, 1, At, B1); PG8_BAR; PG8_SCHED;
            PG8_LDB(B0, 1, 0); PG8_LDB(B1, 1, 1); PG8_SCHED; PG8_LDA(At, 1, 0); PG8_STAGE(PG8_SA(0, 1), a2 + hstep, voffA);
            PG8_WAIT_V(8); PG8_WAIT_L(0); PG8_BAR; PG8_MMA(0, 0, At, B0); PG8_MMA(0, 1, At, B1); PG8_BAR; PG8_SCHED;
            PG8_LDA(At, 1, 1); PG8_STAGE(PG8_SB(1, 0), b3, voffB); PG8_STAGE(PG8_SB(1, 1), b3 + hstep, voffB); PG8_STAGE(PG8_SA(1, 0), a3, voffA);
            PG8_WAIT_V(8); PG8_WAIT_L(0); PG8_BAR; PG8_MMA(1, 0, At, B0); PG8_MMA(1, 1, At, B1); PG8_BAR; PG8_SCHED;
            } else {
            PG8_LDB(B0, 0, 0); PG8_SCHED; PG8_LDA(At, 0, 0); PG8_STAGE(PG8_SA(1, 1), a1 + hstep, voffA);
            PG8_WAIT_L(8); PG8_BAR; PG8_WAIT_L(0); PG8_MMA(0, 0, At, B0); PG8_BAR; PG8_SCHED;
            PG8_LDB(B1, 0, 1); PG8_STAGE(PG8_SB(0, 0), b2, voffB);
            PG8_BAR; PG8_WAIT_L(0); PG8_MMA(0, 1, At, B1); PG8_BAR;
            PG8_LDA(At, 0, 1); PG8_STAGE(PG8_SA(0, 0), a2, voffA);
            PG8_BAR; PG8_WAIT_L(0); PG8_MMA(1, 0, At, B0); PG8_BAR; PG8_SCHED;
            PG8_STAGE(PG8_SB(0, 1), b2 + hstep, voffB);
            PG8_WAIT_V(6); PG8_BAR; PG8_MMA(1, 1, At, B1); PG8_BAR;
            PG8_LDB(B0, 1, 0); PG8_SCHED; PG8_LDA(At, 1, 0); PG8_STAGE(PG8_SA(0, 1), a2 + hstep, voffA);
            PG8_WAIT_L(8); PG8_BAR; PG8_WAIT_L(0); PG8_MMA(0, 0, At, B0); PG8_BAR; PG8_SCHED;
            PG8_LDB(B1, 1, 1); PG8_STAGE(PG8_SB(1, 0), b3, voffB);
            PG8_BAR; PG8_WAIT_L(0); PG8_MMA(0, 1, At, B1); PG8_BAR;
            PG8_LDA(At, 1, 1); PG8_STAGE(PG8_SA(1, 0), a3, voffA);
            PG8_BAR; PG8_WAIT_L(0); PG8_MMA(1, 0, At, B0); PG8_BAR; PG8_SCHED;
            PG8_STAGE(PG8_SB(1, 1), b3 + hstep, voffB);
            PG8_WAIT_V(6); PG8_BAR; PG8_MMA(1, 1, At, B1); PG8_BAR;
            }
        }
        if constexpr (ALIGN_EPI) { if (wr == 0) PG8_BAR; }
        if constexpr (!Epi::AFTER_DRAIN) { E(acc, cur, wr, wc, fr, fq); S.done(cur); }
        if (!has_next) break;
#pragma unroll
        for (int a = 0; a < 2; ++a)
#pragma unroll
            for (int b = 0; b < 2; ++b)
#pragma unroll
                for (int m = 0; m < 4; ++m)
#pragma unroll
                    for (int n = 0; n < 2; ++n) acc[a][b][m][n] = (f32x4){0.f, 0.f, 0.f, 0.f};
        cur = nxt; cA = nA; cB = nB; ++ui;
        if constexpr (ALIGN_EPI) { if (wr == 1) PG8_BAR; }
    }
    PG8_WAIT_V(0);
    if constexpr (!ALIGN_EPI) { if (wr == 0) PG8_BAR; }
    PG8_BAR;
    if constexpr (Epi::AFTER_DRAIN) { E.fused(acc, cur, wr, wc, fr, fq, lds, wid, lane); S.done(cur); }
#undef PG8_SA
#undef PG8_SB
#undef PG8_STAGE
#undef PG8_LDA
#undef PG8_LDB
#undef PG8_MMA
#undef PG8_WAIT_V
#undef PG8_WAIT_V8_OR
#undef PG8_WAIT_L
#undef PG8_BAR
#undef PG8_SCHED
}
}

#ifndef PG8_SP2
#define PG8_SP2 true
#endif
#ifndef PG8_ALIGN
#define PG8_ALIGN true
#endif
#include <hip/hip_bf16.h>
#include <cmath>
namespace attn_body {
using bf16=__hip_bfloat16;
using bf16x8=__attribute__((ext_vector_type(8)))short;
using s16x4=__attribute__((ext_vector_type(4)))short;
using f32x16=__attribute__((ext_vector_type(16)))float;
using u32x4=__attribute__((ext_vector_type(4)))unsigned;
constexpr int SEQ=2048,D=64,PQ=64,MROWS=65536;
constexpr int NW=8,QBLK=32,QB=QBLK*NW,KVBLK=64,NQB=SEQ/QB;
constexpr int ATTN_UNIT_ROWS=QB;
__device__ __forceinline__ int crow(int r,int hi){return (r&3)+8*(r>>2)+4*hi;}
#define SBAR() __builtin_amdgcn_sched_barrier(0)
__device__ __forceinline__ void cmask(f32x16&p0,f32x16&p1,int jb,int qrel,int hi){
  const float NEG=-INFINITY; int d=qrel-64*jb-4*hi; asm volatile("":"+v"(d));
  #pragma unroll
  for(int r=0;r<16;++r){const int c=(r&3)+8*(r>>2); if(c>d)p0[r]=NEG; if(c+32>d)p1[r]=NEG;}
}

constexpr int NSLOT=3, SLOTB=8192;
constexpr int LDS_K=0, LDS_V=NSLOT*SLOTB, LDS_WS=3*NSLOT*SLOTB  , LDS_OST=LDS_WS+NW*64*4, LDS_BYTES=LDS_OST+NW*4096;
constexpr float C2=0.125f*1.4426950408889634f;
__device__ __forceinline__ void glds16(const void*gsrc,unsigned lds_dst){unsigned keep;
  asm volatile("s_mov_b32 %0, m0\n\ts_mov_b32 m0, %2\n\ts_nop 0\n\tglobal_load_lds_dwordx4 %1, off\n\ts_mov_b32 m0, %0":"=&s"(keep):"v"(gsrc),"s"(lds_dst):"memory");}
__device__ __forceinline__ void glds16s(const void*sbase,unsigned voff,unsigned lds_dst){unsigned keep;
  asm volatile("s_mov_b32 %0, m0\n\ts_mov_b32 m0, %2\n\ts_nop 0\n\tglobal_load_lds_dwordx4 %1, %3\n\ts_mov_b32 m0, %0":"=&s"(keep):"v"(voff),"s"(lds_dst),"s"(sbase):"memory");}
__device__ __forceinline__ float max3f(float a,float b,float c){float r;asm("v_max3_f32 %0, %1, %2, %3":"=v"(r):"v"(a),"v"(b),"v"(c));return r;}
__device__ __forceinline__ float max2f(float a,float b){float r;asm("v_max_f32_e32 %0, %1, %2":"=v"(r):"v"(a),"v"(b));return r;}
__device__ __forceinline__ float fadd_s(float a,float b){float r;asm("v_add_f32_e32 %0, %1, %2":"=v"(r):"v"(a),"v"(b));return r;}
__device__ __forceinline__ float fsub_s(float a,float b){float r;asm("v_sub_f32_e32 %0, %1, %2":"=v"(r):"v"(a),"v"(b));return r;}
typedef float f32x4_t __attribute__((ext_vector_type(4))); typedef float f32x2_t __attribute__((ext_vector_type(2))); typedef __bf16 bf16x2_t __attribute__((ext_vector_type(2)));
__device__ __forceinline__ unsigned cvtpk_s(float lo,float hi){f32x2_t v={lo,hi};bf16x2_t b=__builtin_convertvector(v,bf16x2_t);return __builtin_bit_cast(unsigned,b);}
#define WAIT_BAR(N) asm volatile("s_waitcnt vmcnt(" #N ") lgkmcnt(0)\n\ts_barrier":::"memory")

__device__ __forceinline__ void qkt(f32x16&p0,f32x16&p1,const char*Kslot,const bf16x8*qr,const f32x16&negm,int r32,int hi){
  const char*kb=Kslot+hi*1024+r32*16;
  #pragma unroll
  for(int d0=0;d0<4;++d0){
    const bf16x8 b0=*reinterpret_cast<const bf16x8*>(kb+d0*2048);
    const bf16x8 b1=*reinterpret_cast<const bf16x8*>(kb+d0*2048+512);
    if(d0==0){p0=__builtin_amdgcn_mfma_f32_32x32x16_bf16(b0,qr[0],negm,0,0,0);p1=__builtin_amdgcn_mfma_f32_32x32x16_bf16(b1,qr[0],negm,0,0,0);}
    else{p0=__builtin_amdgcn_mfma_f32_32x32x16_bf16(b0,qr[d0],p0,0,0,0);p1=__builtin_amdgcn_mfma_f32_32x32x16_bf16(b1,qr[d0],p1,0,0,0);}}
}
typedef __attribute__((address_space(3))) const char* lds_cptr;
typedef short v4i16_t __attribute__((ext_vector_type(4)));
__device__ __forceinline__ void kload8(bf16x8*kf,lds_cptr kp){
  kf[0]=*(const __attribute__((address_space(3))) bf16x8*)(kp);      kf[1]=*(const __attribute__((address_space(3))) bf16x8*)(kp+512);
  kf[2]=*(const __attribute__((address_space(3))) bf16x8*)(kp+2048); kf[3]=*(const __attribute__((address_space(3))) bf16x8*)(kp+2560);
  kf[4]=*(const __attribute__((address_space(3))) bf16x8*)(kp+4096); kf[5]=*(const __attribute__((address_space(3))) bf16x8*)(kp+4608);
  kf[6]=*(const __attribute__((address_space(3))) bf16x8*)(kp+6144); kf[7]=*(const __attribute__((address_space(3))) bf16x8*)(kp+6656);
}
__device__ __forceinline__ void kload2(bf16x8*kf,lds_cptr kp,int j){ kf[2*j]=*(const __attribute__((address_space(3))) bf16x8*)(kp+j*2048); kf[2*j+1]=*(const __attribute__((address_space(3))) bf16x8*)(kp+j*2048+512); }
__device__ __forceinline__ s16x4 vtr(lds_cptr p){ return __builtin_bit_cast(s16x4,__builtin_amdgcn_ds_read_tr16_b64_v4i16((__attribute__((address_space(3))) v4i16_t*)p)); }
__device__ __forceinline__ float rowmax(const f32x16&p0,const f32x16&p1){
  float a=max3f(p0[0],p0[1],p1[0]),b=max3f(p0[2],p0[3],p1[1]);a=max3f(a,p1[2],p1[3]);
  #pragma unroll
  for(int r=4;r<16;r+=4){a=max3f(a,p0[r],p0[r+1]);b=max3f(b,p0[r+2],p0[r+3]);a=max3f(a,p1[r],p1[r+1]);b=max3f(b,p1[r+2],p1[r+3]);}
  const float m=max2f(a,b);
  auto rr=__builtin_amdgcn_permlane32_swap(__float_as_uint(m),__float_as_uint(m),false,false);
  return max2f(__uint_as_float(rr[0]),__uint_as_float(rr[1]));
}
__device__ __forceinline__ void pv(f32x16*o,int vb,bf16x8 pa0,bf16x8 pa1,bf16x8 pa2,bf16x8 pa3){
  #pragma unroll
  for(int d0=0;d0<2;++d0){s16x4 lo[4],hi[4];
    #pragma unroll
    for(int ks=0;ks<4;++ks){
      asm volatile("ds_read_b64_tr_b16 %0,%1 offset:%c2":"=&v"(lo[ks]):"v"(vb),"i"(d0*4096+ks*1024):"memory");
      asm volatile("ds_read_b64_tr_b16 %0,%1 offset:%c2":"=&v"(hi[ks]):"v"(vb),"i"(d0*4096+ks*1024+512):"memory");}
    asm volatile("s_waitcnt lgkmcnt(0)":::"memory");SBAR();
    #define PK(k) (bf16x8){lo[k][0],lo[k][1],lo[k][2],lo[k][3],hi[k][0],hi[k][1],hi[k][2],hi[k][3]}
    o[d0]=__builtin_amdgcn_mfma_f32_32x32x16_bf16(pa0,PK(0),o[d0],0,0,0);
    o[d0]=__builtin_amdgcn_mfma_f32_32x32x16_bf16(pa1,PK(1),o[d0],0,0,0);
    o[d0]=__builtin_amdgcn_mfma_f32_32x32x16_bf16(pa2,PK(2),o[d0],0,0,0);
    o[d0]=__builtin_amdgcn_mfma_f32_32x32x16_bf16(pa3,PK(3),o[d0],0,0,0);
    #undef PK
  }
}

#ifndef ATTN_STORE16
#define ATTN_STORE16(p,v) (*(u32x4*)(p)=(v))
#endif
__device__ __forceinline__ void attn_prefetch(const bf16*Qh,const bf16*Kh,int qb,bf16x8(&qn)[4],char*shm,const int wave_s){
  const int tid=tid_now(wave_s),lane=tid&63,r32=lane&31,hi=lane>>5; const int wid=__builtin_amdgcn_readfirstlane(tid>>6);
  const unsigned lds0=(unsigned)(uintptr_t)shm; const unsigned koff=(unsigned)((lane*PQ+wid*8)*2); const unsigned kdst=lds0+LDS_K+wid*1024;
  glds16s(Kh,koff,(unsigned)__builtin_amdgcn_readfirstlane(kdst)); glds16s(Kh+(long)KVBLK*PQ,koff,(unsigned)__builtin_amdgcn_readfirstlane(kdst+SLOTB)); glds16s(Kh+(long)2*KVBLK*PQ,koff,(unsigned)__builtin_amdgcn_readfirstlane(kdst+2*SLOTB));
  const char*Qw=(const char*)(Qh+(long)(qb*QB+wid*QBLK)*PQ); const unsigned qoff=(unsigned)((r32*PQ+hi*8)*2);
  #pragma unroll
  for(int d0=0;d0<4;++d0)qn[d0]=*reinterpret_cast<const bf16x8*>(Qw+qoff+d0*32);
}
struct EpiArgs { int mode; bf16* out; const bf16* z; const bf16* od; const float* gsub; const float* lq1; const float* lk1; const float* lq2; const float* lk2; };
template<int THRL,bool WIDE> __device__ __forceinline__ void attn_unit(int qb,bf16x8(&qr)[4],const bf16*__restrict__ Kh,const bf16*__restrict__ Vh,const EpiArgs EA,const float*kmean,const bool has_next,const bf16*Qn,const bf16*Kn,int qbn,char*shm,const int wave_s){
  const int tid=tid_now(wave_s),lane=tid&63,r32=lane&31,hi=lane>>5; const int wid=__builtin_amdgcn_readfirstlane(tid>>6);
  constexpr bool MOBA=!WIDE;
  const int q0=qb*QB;
  const unsigned lds0=(unsigned)(uintptr_t)shm;
  float*wsf=(float*)(shm+LDS_WS)+wid*64;
  const unsigned koff=(unsigned)((lane*PQ+wid*8)*2);
  const unsigned voff=(unsigned)(((16*(wid&3)+(lane>>2))*PQ+(wid>>2)*32+(lane&3)*8)*2);
  const unsigned kdst=lds0+LDS_K+wid*1024, vdst=lds0+LDS_V+wid*1024;
  #define DMA_K(t,slot) glds16s(Kh+(long)(t)*KVBLK*PQ,koff,(unsigned)__builtin_amdgcn_readfirstlane(kdst+(slot)))
  #define DMA_V(t,slot) do{ glds16s(Vh+(long)(t)*KVBLK*PQ,voff,(unsigned)__builtin_amdgcn_readfirstlane(vdst+2*(slot))); \
    if constexpr(WIDE) glds16s(Vh+(long)MROWS*64+(long)(t)*KVBLK*PQ,voff,(unsigned)__builtin_amdgcn_readfirstlane(vdst+2*(slot)+8192)); }while(0)
  #define WB(a,b) do{ if constexpr(WIDE){WAIT_BAR(b);} else {WAIT_BAR(a);} }while(0)
  const int vb0=(int)(lds0+LDS_V)+((lane>>4)&1)*32+(lane&3)*8+(4*hi+((lane&15)>>2))*64;
  const char*Kbase=shm+LDS_K; bf16x8 kf[8];
  const lds_cptr shm3=(lds_cptr)shm; const lds_cptr kp0=shm3+LDS_K+hi*1024+r32*16; const lds_cptr vp0=shm3+LDS_V+((lane>>4)&1)*32+(lane&3)*8+(4*hi+((lane&15)>>2))*64;
  const int NT=(q0+QB)/KVBLK;
  DMA_V(0,0);

  unsigned selmask=0xffu;
  if(MOBA && qb>=4){
    float g[7]; int hio=hi; asm volatile("":"+v"(hio));
    #pragma unroll
    for(int blk=0;blk<7;++blk){ float s=-INFINITY;
      if(blk<qb){ const float*km=kmean+blk*1024+hio*8; float a=0.f;
        #pragma unroll
        for(int d0=0;d0<4;++d0){ const f32x4_t ka=*reinterpret_cast<const f32x4_t*>(km+d0*16)+*reinterpret_cast<const f32x4_t*>(km+512+d0*16), kb2=*reinterpret_cast<const f32x4_t*>(km+d0*16+4)+*reinterpret_cast<const f32x4_t*>(km+512+d0*16+4);
          #pragma unroll
          for(int e=0;e<4;++e){ a+=__uint_as_float(((unsigned)(unsigned short)qr[d0][e])<<16)*ka[e]; a+=__uint_as_float(((unsigned)(unsigned short)qr[d0][4+e])<<16)*kb2[e]; } }
        s=a+__shfl_xor(a,32); }
      g[blk]=s; }
    selmask=1u<<qb;
    #pragma unroll
    for(int blk=0;blk<7;++blk){ int rank=0;
      #pragma unroll
      for(int b2=0;b2<7;++b2){ if(b2!=blk) rank+=((g[b2]>g[blk])||(g[b2]==g[blk]&&b2<blk))?1:0; }
      if(blk<qb&&rank<3) selmask|=1u<<blk; }
  }
  #define BMASK(P0,P1,t) do{ if(MOBA && (t)<NT-4){ if(!((selmask>>((t)>>2))&1u)){ _Pragma("unroll") for(int r_=0;r_<16;++r_){P0[r_]=-INFINITY;P1[r_]=-INFINITY;} } } }while(0)
  float mhat=0.f,l_reg=0.f;constexpr int NO=WIDE?4:2; f32x16 o[NO];
  #pragma unroll
  for(int d_=0;d_<NO;++d_)o[d_]=f32x16{};
  f32x16 negm=f32x16{};
  const int qrel=wid*QBLK+r32;
  #define CMASK(P0,P1,t) do{int jb_=(t)-(NT-4); if(jb_>=0)cmask(P0,P1,jb_,qrel,hi); else BMASK(P0,P1,t);}while(0)
  bool resc=false;
  #define START(P0,P1) do{ const float rm=rowmax(P0,P1); resc=false; \
    { const float dl=MOBA?__builtin_fmaxf(rm,-1000.f):rm; mhat=fadd_s(mhat,dl); \
      _Pragma("unroll") for(int r=0;r<16;++r){P0[r]=fsub_s(P0[r],dl);P1[r]=fsub_s(P1[r],dl);} \
      if constexpr(!WIDE){ _Pragma("unroll") for(int r=0;r<16;++r)negm[r]=-mhat; asm volatile("":"+v"(negm)); } } \
    _Pragma("unroll") for(int r=0;r<16;++r)P0[r]=__builtin_amdgcn_exp2f(P0[r]); }while(0)
  #define RESC() do{ if(resc){ asm volatile("s_waitcnt lgkmcnt(0)":::"memory"); \
      _Pragma("unroll") for(int d_=0;d_<NO;++d_) _Pragma("unroll") for(int r=0;r<16;++r)o[d_][r]*=wsb[(r&3)+8*(r>>2)]; } }while(0)
  typedef __attribute__((address_space(3))) const float* lds_fptr; const lds_fptr wsb=(lds_fptr)(shm3+LDS_WS)+wid*64+4*hi;
  f32x16 pA0,pA1,pB0,pB1; u32x4 pw0,pw1,pw2,pw3;
  u32x4 qw0,qw1,qw2,qw3; float sacc_c=0.f;
  int sl_prev=0,sl_cur=0,sl_next=SLOTB;
  #define ROT() do{sl_prev=sl_cur;sl_cur=sl_next;sl_next=(sl_next==(NSLOT-1)*SLOTB)?0:sl_next+SLOTB;}while(0)
  WB(1,2);
  qkt(pA0,pA1,Kbase,qr,negm,r32,hi);asm volatile("s_nop 15\n\ts_nop 7":"+v"(pA0),"+v"(pA1));CMASK(pA0,pA1,0);
  START(pA0,pA1);
  _Pragma("unroll") for(int r=0;r<16;++r)pA1[r]=__builtin_amdgcn_exp2f(pA1[r]);
  if constexpr(WIDE){ float s0_=pA0[0]+pA0[1]; _Pragma("unroll") for(int r=2;r<16;++r)s0_+=pA0[r]; _Pragma("unroll") for(int r=0;r<16;++r)s0_+=pA1[r]; sacc_c=s0_;
    pw0=(u32x4){cvtpk_s(pA0[0],pA0[1]),cvtpk_s(pA0[2],pA0[3]),cvtpk_s(pA0[4],pA0[5]),cvtpk_s(pA0[6],pA0[7])};pw1=(u32x4){cvtpk_s(pA0[8],pA0[9]),cvtpk_s(pA0[10],pA0[11]),cvtpk_s(pA0[12],pA0[13]),cvtpk_s(pA0[14],pA0[15])};
    pw2=(u32x4){cvtpk_s(pA1[0],pA1[1]),cvtpk_s(pA1[2],pA1[3]),cvtpk_s(pA1[4],pA1[5]),cvtpk_s(pA1[6],pA1[7])};pw3=(u32x4){cvtpk_s(pA1[8],pA1[9]),cvtpk_s(pA1[10],pA1[11]),cvtpk_s(pA1[12],pA1[13]),cvtpk_s(pA1[14],pA1[15])}; }
  WAIT_BAR(0);
  DMA_K(3,0);DMA_V(1,SLOTB);
  ROT();
  kload8(kf,kp0+sl_cur);
  WB(2,3);
  s16x4 vlo[8],vhi[8];
  #define PKW(P,B) cvtpk_s(P[B],P[B+1])
  #define PAF(k) __builtin_bit_cast(bf16x8,pw##k)
  #define PAFX(S,k) __builtin_bit_cast(bf16x8,S##k)
  #define SP(X,B,PW,c) do{ sacc_c+=X[B]; sacc_c+=X[B+1]; PW[c]=PKW(X,B); PIN(sacc_c); PIN(PW); }while(0)
  #define GW(MF,X,B,SPX) do{ MF; X[B]=EX(X[B]); X[B+1]=EX(X[B+1]); SPX; SBAR(); }while(0)
  #define VFR(i) (bf16x8){vlo[i][0],vlo[i][1],vlo[i][2],vlo[i][3],vhi[i][0],vhi[i][1],vhi[i][2],vhi[i][3]}
  #define PIN(x) asm volatile("":"+v"(x))
  #define MX3(a,b,c) __builtin_fmaxf(__builtin_fmaxf((a),(b)),(c))
  #define GAPA(MF,A0,A1,A2,A3,W0,W1,PW) do{ MF; sacc+=A0; sacc+=A1; sacc+=A2; sacc+=A3; PIN(sacc); W0; W1; PIN(PW); SBAR(); }while(0)
  #define EX(v) __builtin_amdgcn_exp2f(v)
  #define GAPB(MF,X,B) do{ MF; X[B]=EX(X[B]); X[B+1]=EX(X[B+1]); X[B+2]=EX(X[B+2]); X[B+3]=EX(X[B+3]); PIN(X); SBAR(); }while(0)
  #define VRD(i) do{ vlo[i]=vtr(vp_+(((i)>>2)*4096+((i)&3)*1024)); vhi[i]=vtr(vp_+(((i)>>2)*4096+((i)&3)*1024+512)); }while(0)
  #define KRD(G,j) do{ if(G){ kload2(kf,kp0+sl_next,j); SBAR(); } }while(0)
  #define VRD2(i) do{ if constexpr(WIDE){ vlo[i]=vtr(vp_+8192+(((i)>>2)*4096+((i)&3)*1024)); vhi[i]=vtr(vp_+8192+(((i)>>2)*4096+((i)&3)*1024+512)); SBAR(); } }while(0)
  #define STEP(C0,C1,P0,P1,t,GK,GV,GL,PWC,PWN) do{ SBAR(); \
    const lds_cptr vp_=vp0+2*sl_prev; \
    float sacc=0.f; if constexpr(!WIDE) sacc=(P0[0]+P0[1]); \
    if constexpr(WIDE){   \
      VRD(0); SBAR(); C0=__builtin_amdgcn_mfma_f32_32x32x16_bf16(kf[0],qr[0],negm,0,0,0); SBAR(); \
      VRD(4); SBAR(); C1=__builtin_amdgcn_mfma_f32_32x32x16_bf16(kf[1],qr[0],negm,0,0,0); SBAR(); \
      VRD(1); SBAR(); C0=__builtin_amdgcn_mfma_f32_32x32x16_bf16(kf[2],qr[1],C0,0,0,0); SBAR(); \
      VRD(5); SBAR(); C1=__builtin_amdgcn_mfma_f32_32x32x16_bf16(kf[3],qr[1],C1,0,0,0); SBAR(); \
      VRD(2); SBAR(); C0=__builtin_amdgcn_mfma_f32_32x32x16_bf16(kf[4],qr[2],C0,0,0,0); SBAR(); \
      VRD(6); SBAR(); C1=__builtin_amdgcn_mfma_f32_32x32x16_bf16(kf[5],qr[2],C1,0,0,0); SBAR(); \
      VRD(3); SBAR(); C0=__builtin_amdgcn_mfma_f32_32x32x16_bf16(kf[6],qr[3],C0,0,0,0); SBAR(); \
      VRD(7); SBAR(); C1=__builtin_amdgcn_mfma_f32_32x32x16_bf16(kf[7],qr[3],C1,0,0,0); SBAR(); \
    } else { \
    VRD(0); SBAR(); \
    GAPA(C0=__builtin_amdgcn_mfma_f32_32x32x16_bf16(kf[0],qr[0],negm,0,0,0), P0[2],P0[3],P0[4],P0[5],     pw0[0]=PKW(P0,0), pw0[1]=PKW(P0,2), pw0); \
    VRD(4); SBAR(); GAPA(C1=__builtin_amdgcn_mfma_f32_32x32x16_bf16(kf[1],qr[0],negm,0,0,0), P0[6],P0[7],P0[8],P0[9],     pw0[2]=PKW(P0,4), pw0[3]=PKW(P0,6), pw0); \
    VRD(1); SBAR(); GAPA(C0=__builtin_amdgcn_mfma_f32_32x32x16_bf16(kf[2],qr[1],C0,0,0,0),   P0[10],P0[11],P0[12],P0[13], pw1[0]=PKW(P0,8), pw1[1]=PKW(P0,10), pw1); \
    VRD(5); SBAR(); GAPA(C1=__builtin_amdgcn_mfma_f32_32x32x16_bf16(kf[3],qr[1],C1,0,0,0),   P0[14],P0[15],P1[0],P1[1],   pw1[2]=PKW(P0,12),pw1[3]=PKW(P0,14), pw1); \
    VRD(2); SBAR(); GAPA(C0=__builtin_amdgcn_mfma_f32_32x32x16_bf16(kf[4],qr[2],C0,0,0,0),   P1[2],P1[3],P1[4],P1[5],     pw2[0]=PKW(P1,0), pw2[1]=PKW(P1,2), pw2); \
    VRD(6); SBAR(); GAPA(C1=__builtin_amdgcn_mfma_f32_32x32x16_bf16(kf[5],qr[2],C1,0,0,0),   P1[6],P1[7],P1[8],P1[9],     pw2[2]=PKW(P1,4), pw2[3]=PKW(P1,6), pw2); \
    VRD(3); SBAR(); GAPA(C0=__builtin_amdgcn_mfma_f32_32x32x16_bf16(kf[6],qr[3],C0,0,0,0),   P1[10],P1[11],P1[12],P1[13], pw3[0]=PKW(P1,8), pw3[1]=PKW(P1,10), pw3); \
    VRD(7); SBAR(); GAPA(C1=__builtin_amdgcn_mfma_f32_32x32x16_bf16(kf[7],qr[3],C1,0,0,0),   P1[14],P1[15],0.f,0.f,       pw3[2]=PKW(P1,12),pw3[3]=PKW(P1,14), pw3); \
    } \
    if constexpr(WIDE){ l_reg+=sacc_c; sacc_c=0.f; } else { l_reg+=sacc; } \
    if(GK){DMA_K((t)+3,sl_cur);} if(GV){DMA_V((t)+1,sl_next);} \
    CMASK(C0,C1,t); \
    if constexpr(WIDE){ _Pragma("unroll") for(int r=0;r<16;++r){C0[r]-=mhat;C1[r]-=mhat;} } \
    { float a=MX3(C0[0],C0[1],C1[0]),b=MX3(C0[2],C0[3],C1[1]); a=MX3(a,C1[2],C1[3]); \
      _Pragma("unroll") for(int r=4;r<16;r+=4){a=MX3(a,C0[r],C0[r+1]);b=MX3(b,C0[r+2],C0[r+3]);a=MX3(a,C1[r],C1[r+1]);b=MX3(b,C1[r+2],C1[r+3]);} \
      float rm=__builtin_fmaxf(a,b); { auto rr=__builtin_amdgcn_permlane32_swap(__float_as_uint(rm),__float_as_uint(rm),false,false); rm=__builtin_fmaxf(__uint_as_float(rr[0]),__uint_as_float(rr[1])); } \
      resc=false; \
      if(__builtin_expect(__any(rm>(float)THRL),0)){ const float dl=__builtin_fmaxf(rm,0.f); mhat+=dl; \
        _Pragma("unroll") for(int r=0;r<16;++r){C0[r]-=dl;C1[r]-=dl;} \
        if constexpr(!WIDE){ _Pragma("unroll") for(int r=0;r<16;++r)negm[r]=-mhat; asm volatile("":"+v"(negm)); } \
        const float f=__builtin_amdgcn_exp2f(-dl); l_reg*=f; if(hi==0)wsf[r32]=f; resc=true; } } \
    SBAR(); \
    if constexpr(WIDE){ \
      GW(o[0]=__builtin_amdgcn_mfma_f32_32x32x16_bf16(PAFX(PWC,0),VFR(0),o[0],0,0,0), C0,0,  (void)0); VRD2(0); \
      GW(o[1]=__builtin_amdgcn_mfma_f32_32x32x16_bf16(PAFX(PWC,0),VFR(4),o[1],0,0,0), C0,4,  SP(C0,0,PWN##0,0)); VRD2(4); \
      GW(o[0]=__builtin_amdgcn_mfma_f32_32x32x16_bf16(PAFX(PWC,1),VFR(1),o[0],0,0,0), C0,8,  SP(C0,4,PWN##0,2)); VRD2(1); \
      GW(o[1]=__builtin_amdgcn_mfma_f32_32x32x16_bf16(PAFX(PWC,1),VFR(5),o[1],0,0,0), C0,12, SP(C0,8,PWN##1,0)); VRD2(5); \
      GW(o[0]=__builtin_amdgcn_mfma_f32_32x32x16_bf16(PAFX(PWC,2),VFR(2),o[0],0,0,0), C1,0,  SP(C0,12,PWN##1,2)); VRD2(2); \
      GW(o[1]=__builtin_amdgcn_mfma_f32_32x32x16_bf16(PAFX(PWC,2),VFR(6),o[1],0,0,0), C1,4,  SP(C1,0,PWN##2,0)); VRD2(6); \
      GW(o[0]=__builtin_amdgcn_mfma_f32_32x32x16_bf16(PAFX(PWC,3),VFR(3),o[0],0,0,0), C1,8,  SP(C1,4,PWN##2,2)); VRD2(3); \
      GW(o[1]=__builtin_amdgcn_mfma_f32_32x32x16_bf16(PAFX(PWC,3),VFR(7),o[1],0,0,0), C1,12, SP(C1,8,PWN##3,0)); VRD2(7); \
        \
      GW(o[2]=__builtin_amdgcn_mfma_f32_32x32x16_bf16(PAFX(PWC,0),VFR(0),o[2],0,0,0), C0,2,  SP(C1,12,PWN##3,2)); \
      GW(o[3]=__builtin_amdgcn_mfma_f32_32x32x16_bf16(PAFX(PWC,0),VFR(4),o[3],0,0,0), C0,6,  SP(C0,2,PWN##0,1)); \
      KRD(GL,0); GW(o[2]=__builtin_amdgcn_mfma_f32_32x32x16_bf16(PAFX(PWC,1),VFR(1),o[2],0,0,0), C0,10, SP(C0,6,PWN##0,3)); \
      KRD(GL,1); GW(o[3]=__builtin_amdgcn_mfma_f32_32x32x16_bf16(PAFX(PWC,1),VFR(5),o[3],0,0,0), C0,14, SP(C0,10,PWN##1,1)); \
      KRD(GL,2); GW(o[2]=__builtin_amdgcn_mfma_f32_32x32x16_bf16(PAFX(PWC,2),VFR(2),o[2],0,0,0), C1,2,  SP(C0,14,PWN##1,3)); \
      KRD(GL,3); GW(o[3]=__builtin_amdgcn_mfma_f32_32x32x16_bf16(PAFX(PWC,2),VFR(6),o[3],0,0,0), C1,6,  SP(C1,2,PWN##2,1)); \
      GW(o[2]=__builtin_amdgcn_mfma_f32_32x32x16_bf16(PAFX(PWC,3),VFR(3),o[2],0,0,0), C1,10, SP(C1,6,PWN##2,3)); \
      GW(o[3]=__builtin_amdgcn_mfma_f32_32x32x16_bf16(PAFX(PWC,3),VFR(7),o[3],0,0,0), C1,14, SP(C1,10,PWN##3,1)); \
      SP(C1,14,PWN##3,3); SBAR(); \
    } else { \
    GAPB(o[0]=__builtin_amdgcn_mfma_f32_32x32x16_bf16(PAF(0),VFR(0),o[0],0,0,0), C0,0); VRD2(0); \
    GAPB(o[1]=__builtin_amdgcn_mfma_f32_32x32x16_bf16(PAF(0),VFR(4),o[1],0,0,0), C0,4); VRD2(4); \
    KRD(GL,0); GAPB(o[0]=__builtin_amdgcn_mfma_f32_32x32x16_bf16(PAF(1),VFR(1),o[0],0,0,0), C0,8); VRD2(1); \
    KRD(GL,1); GAPB(o[1]=__builtin_amdgcn_mfma_f32_32x32x16_bf16(PAF(1),VFR(5),o[1],0,0,0), C0,12); VRD2(5); \
    KRD(GL,2); GAPB(o[0]=__builtin_amdgcn_mfma_f32_32x32x16_bf16(PAF(2),VFR(2),o[0],0,0,0), C1,0); VRD2(2); \
    KRD(GL,3); GAPB(o[1]=__builtin_amdgcn_mfma_f32_32x32x16_bf16(PAF(2),VFR(6),o[1],0,0,0), C1,4); VRD2(6); \
    GAPB(o[0]=__builtin_amdgcn_mfma_f32_32x32x16_bf16(PAF(3),VFR(3),o[0],0,0,0), C1,8); VRD2(3); \
    GAPB(o[1]=__builtin_amdgcn_mfma_f32_32x32x16_bf16(PAF(3),VFR(7),o[1],0,0,0), C1,12); VRD2(7); \
    } \
    }while(0)
  int t=1;
  #undef CMASK
  #define CMASK(P0,P1,t) BMASK(P0,P1,t)
  for(;t+5<NT;t+=2){
    STEP(pB0,pB1,pA0,pA1,t,true,true,true,pw,qw);     WB(2,3); RESC(); ROT();
    STEP(pA0,pA1,pB0,pB1,t+1,true,true,true,qw,pw);   WB(2,3); RESC(); ROT();
  }
  #undef CMASK
  #define CMASK(P0,P1,t) do{int jb_=(t)-(NT-4); if(jb_>=0)cmask(P0,P1,jb_,qrel,hi); else BMASK(P0,P1,t);}while(0)
  #define ENDW(tt) do{ if((tt)+3<NT){WB(2,3);} else if((tt)+2<NT){WB(1,2);} else {WAIT_BAR(0);} }while(0)
  for(;t+1<NT;t+=2){
    STEP(pB0,pB1,pA0,pA1,t,(t+3<NT),(t+1<NT),(t+1<NT),pw,qw);       ENDW(t);   RESC(); ROT();
    STEP(pA0,pA1,pB0,pB1,t+1,(t+4<NT),(t+2<NT),(t+2<NT),qw,pw);     ENDW(t+1); RESC(); ROT();
  }
  STEP(pB0,pB1,pA0,pA1,NT-1,false,false,false,pw,qw); RESC();
  int le=lane; asm volatile("":"+v"(le)); const int r32e=le&31,hie=le>>5;
  if(has_next) attn_prefetch(Qn,Kn,qbn,qr,shm,wave_s);
  const long orow0=(long)(q0+wid*QBLK)*1024;
  u32x4 pz[4][2],po[4][2];
  #pragma unroll
  for(int i=0;i<4;++i){ pz[i][0]=u32x4{};pz[i][1]=u32x4{};po[i][0]=u32x4{};po[i][1]=u32x4{}; }
  if(EA.mode!=1){
    #pragma unroll
    for(int i=0;i<4;++i){ const bf16*zp=EA.z+orow0+(long)(i*8+(le>>3))*1024+(le&7)*8; pz[i][0]=*(const u32x4*)(zp); if(EA.mode==2)pz[i][1]=*(const u32x4*)(zp+64); }
    if(EA.mode==2){
      #pragma unroll
      for(int i=0;i<4;++i){ const bf16*odp=EA.od+orow0+(long)(i*8+(le>>3))*1024+(le&7)*8; po[i][0]=*(const u32x4*)(odp); po[i][1]=*(const u32x4*)(odp+64); } }
  }
  if constexpr(WIDE){ l_reg+=sacc_c; SBAR(); pv(o,vb0+2*sl_cur,PAFX(qw,0),PAFX(qw,1),PAFX(qw,2),PAFX(qw,3)); pv(o+2,vb0+2*sl_cur+8192,PAFX(qw,0),PAFX(qw,1),PAFX(qw,2),PAFX(qw,3)); }
  else
  { float sacc=pB0[0]+pB0[1]; _Pragma("unroll") for(int r=2;r<16;++r)sacc+=pB0[r]; _Pragma("unroll") for(int r=0;r<16;++r)sacc+=pB1[r]; l_reg+=sacc;
    pw0=(u32x4){PKW(pB0,0),PKW(pB0,2),PKW(pB0,4),PKW(pB0,6)};pw1=(u32x4){PKW(pB0,8),PKW(pB0,10),PKW(pB0,12),PKW(pB0,14)};pw2=(u32x4){PKW(pB1,0),PKW(pB1,2),PKW(pB1,4),PKW(pB1,6)};pw3=(u32x4){PKW(pB1,8),PKW(pB1,10),PKW(pB1,12),PKW(pB1,14)};
    SBAR(); pv(o,vb0+2*sl_cur,PAF(0),PAF(1),PAF(2),PAF(3)); }
  #undef PKW
  #undef PAF
  #undef VFR
  #undef PIN
  #undef MX3
  #undef GAPA
  #undef GAPB
  #undef GW
  #undef SP
  #undef PAFX
  #undef EX
  #undef VRD
  #undef KRD
  #undef VRD2
  #undef STEP
  #undef ENDW
  {auto rr=__builtin_amdgcn_permlane32_swap(__float_as_uint(l_reg),__float_as_uint(l_reg),false,false);l_reg=__uint_as_float(rr[0])+__uint_as_float(rr[1]);}
  if(hie==0)wsf[32+r32e]=l_reg;asm volatile("s_waitcnt lgkmcnt(0)":::"memory");
  float rli[16];
  #pragma unroll
  for(int r=0;r<16;++r)rli[r]=__builtin_amdgcn_rcpf(wsf[32+crow(r,hie)]);
  { bf16*stg=(bf16*)(shm+LDS_OST)+wid*2048;
    #define BFLO(u) __uint_as_float((u)<<16)
    #define BFHI(u) __uint_as_float((u)&0xffff0000u)
    #pragma unroll
    for(int r=0;r<16;++r){const int orow=crow(r,hie);
      #pragma unroll
      for(int d0=0;d0<2;++d0)stg[orow*64+d0*32+r32e]=__float2bfloat16(o[d0][r]*rli[r]);}
    asm volatile("s_waitcnt lgkmcnt(0)":::"memory");
    if constexpr(!WIDE){
      #pragma unroll
      for(int i=0;i<4;++i){const int row=i*8+(le>>3),ch=le&7; const u32x4 v=*(const u32x4*)(stg+row*64+ch*8); const u32x4 zz=pz[i][0]; u32x4 y;
        #pragma unroll
        for(int e=0;e<4;++e) y[e]=cvtpk_s(BFLO(v[e])*BFLO(zz[e]),BFHI(v[e])*BFHI(zz[e]));
        ATTN_STORE16(EA.out+orow0+(long)row*1024+ch*8,y);}
    } else {
      u32x4 va[4];
      #pragma unroll
      for(int i=0;i<4;++i){const int row=i*8+(le>>3),ch=le&7; va[i]=*(const u32x4*)(stg+row*64+ch*8); if(EA.mode==1)ATTN_STORE16(EA.out+orow0+(long)row*1024+ch*8,va[i]);}
      asm volatile("s_waitcnt lgkmcnt(0)":::"memory");
      #pragma unroll
      for(int r=0;r<16;++r){const int orow=crow(r,hie);
        #pragma unroll
        for(int d0=0;d0<2;++d0)stg[orow*64+d0*32+r32e]=__float2bfloat16(o[2+d0][r]*rli[r]);}
      asm volatile("s_waitcnt lgkmcnt(0)":::"memory");
      if(EA.mode==1){
        #pragma unroll
        for(int i=0;i<4;++i){const int row=i*8+(le>>3),ch=le&7; const u32x4 v=*(const u32x4*)(stg+row*64+ch*8); ATTN_STORE16(EA.out+orow0+(long)row*1024+64+ch*8,v);}
      } else {
        float t1=EA.lq1[le]*EA.lk1[le],t2=EA.lq2[le]*EA.lk2[le];
        #pragma unroll
        for(int o_=1;o_<64;o_<<=1){t1+=__shfl_xor(t1,o_);t2+=__shfl_xor(t2,o_);}
        const float lam=__expf(t1)-__expf(t2)+0.2f;
        #pragma unroll
        for(int i=0;i<4;++i){const int row=i*8+(le>>3),ch=le&7; const u32x4 vb=*(const u32x4*)(stg+row*64+ch*8); const u32x4 v0=va[i];
          const u32x4 o00=po[i][0],o01=po[i][1]; const u32x4 za=pz[i][0],zb=pz[i][1];
          float a[8],b[8]; float ss=0.f;
          #pragma unroll
          for(int e=0;e<4;++e){ a[2*e]=BFLO(o00[e])-lam*BFLO(v0[e]); a[2*e+1]=BFHI(o00[e])-lam*BFHI(v0[e]); b[2*e]=BFLO(o01[e])-lam*BFLO(vb[e]); b[2*e+1]=BFHI(o01[e])-lam*BFHI(vb[e]); }
          #pragma unroll
          for(int e=0;e<8;++e) ss+=a[e]*a[e]+b[e]*b[e];
          ss+=__shfl_xor(ss,1); ss+=__shfl_xor(ss,2); ss+=__shfl_xor(ss,4);
          const float rs=__builtin_amdgcn_rsqf(ss*(1.f/128.f)+1e-6f)*0.8f;
          const f32x4_t ga0=*reinterpret_cast<const f32x4_t*>(EA.gsub+ch*8),ga1=*reinterpret_cast<const f32x4_t*>(EA.gsub+ch*8+4),gb0=*reinterpret_cast<const f32x4_t*>(EA.gsub+64+ch*8),gb1=*reinterpret_cast<const f32x4_t*>(EA.gsub+64+ch*8+4);
          u32x4 ya,yb;
          #pragma unroll
          for(int e=0;e<4;++e){ const float g0=(e<2)?ga0[2*e]:ga1[2*e-4], g1=(e<2)?ga0[2*e+1]:ga1[2*e-3], h0=(e<2)?gb0[2*e]:gb1[2*e-4], h1=(e<2)?gb0[2*e+1]:gb1[2*e-3];
            ya[e]=cvtpk_s(a[2*e]*rs*g0*BFLO(za[e]),a[2*e+1]*rs*g1*BFHI(za[e])); yb[e]=cvtpk_s(b[2*e]*rs*h0*BFLO(zb[e]),b[2*e+1]*rs*h1*BFHI(zb[e])); }
          ATTN_STORE16(EA.out+orow0+(long)row*1024+ch*8,ya); ATTN_STORE16(EA.out+orow0+(long)row*1024+64+ch*8,yb);}
      }
    }
    #undef BFLO
    #undef BFHI
  }
  asm volatile("s_waitcnt lgkmcnt(0)\n\ts_barrier":::"memory");
  #undef DMA_K
  #undef DMA_V
  #undef WB
  #undef CMASK
  #undef BMASK
  #undef START
  #undef RESC
  #undef ROT
}
constexpr int ATTN_LDS_BYTES=LDS_BYTES;
struct AttnArgs { const bf16* proj; const bf16* z; bf16* y; bf16* od; const float* kmean; const float* gsub; const float* lq1; const float* lk1; const float* lq2; const float* lk2; };
__device__ __forceinline__ void attn_geom(int i,int j,const bf16*base,const bf16*&q,const bf16*&k,const bf16*&vv,int&qb){
  const bool mb=i<8; const int d=i-8,h=d>>1,mp=d&1; qb=((mb?i:h)&1)?7-j:j;
  const int gq=mb?i:24+h*2+mp, gk=mb?8+i:32+h*2+mp, gv=mb?16+i:40+h*2;
  q=base+(long)gq*MROWS*64; k=base+(long)gk*MROWS*64; vv=base+(long)gv*MROWS*64;
}
template<int THRL=8> __device__ __forceinline__ void attn_phase(char*lds,const AttnArgs&T,int vcu,int G,const int wave_s){
  for(int v=vcu;v<256;v+=G){
    const int g=v>>3,j=v&7; const bf16*base=T.proj+(long)g*SEQ*PQ;
    const long rb=(long)g*SEQ*1024;
    bf16x8 qr[4]; const bf16*q,*k,*vv; int qb; attn_geom(0,j,base,q,k,vv,qb);
    attn_prefetch(q,k,qb,qr,lds,wave_s);
    for(int i=0;i<16;++i){ const bool mb=i<8; const int d=i-8,h=d>>1,mp=d&1;
      attn_geom(i,j,base,q,k,vv,qb);
      const bf16*qn,*kn,*vn; int qbn; attn_geom(i<15?i+1:15,j,base,qn,kn,vn,qbn);
      EpiArgs EA; EA.mode=mb?0:(mp?2:1);
      EA.out=mb?T.y+rb+i*64:(mp?T.y+rb+512+h*128:T.od+rb+h*256);
      EA.z=mb?T.z+rb+i*64:T.z+rb+512+h*128; EA.od=T.od+rb+h*256; EA.gsub=T.gsub; EA.lq1=T.lq1; EA.lk1=T.lk1; EA.lq2=T.lq2; EA.lk2=T.lk2;
      if(mb) attn_unit<THRL,false>(qb,qr,k,vv,EA,T.kmean+g*8192+(i&7)*64,true,qn,kn,qbn,lds,wave_s);
      else   attn_unit<THRL,true>(qb,qr,k,vv,EA,T.kmean,i<15,qn,kn,qbn,lds,wave_s); }
  }
}
#undef SBAR
#undef WAIT_BAR
}
constexpr int NWAVES = 8;
#ifndef MK_N_LAUNCHES
#define MK_N_LAUNCHES 1
#endif
constexpr int N_PHASES = 8;
constexpr int N_LAUNCHES = MK_N_LAUNCHES;
constexpr int BATCH = 32, SEQ = 2048, D = 1024, PLE = 256, PROJ = 4096;
constexpr int M = BATCH * SEQ;
constexpr float EPS = 1e-6f;
constexpr size_t MiB = 1u << 20;
constexpr size_t WS_WIN = 2 * MiB, WS_WOUT = 10 * MiB, WS_WG = 12 * MiB, WS_WPLE = 14 * MiB;
constexpr size_t WS_ROPE = 15 * MiB;
constexpr size_t WS_KMEAN = 16 * MiB;
constexpr size_t WS_CNT = 1 * MiB;
constexpr size_t WS_PART = 20 * MiB;
constexpr size_t WS_PART2 = 24 * MiB;
constexpr size_t WS_PROJ = 32 * MiB;
constexpr size_t WS_Z = 416 * MiB;
constexpr size_t WS_HB = 32 * MiB, WS_PE = 160 * MiB;
constexpr size_t WS_XN = 544 * MiB;
constexpr size_t WS_OM = 672 * MiB;
constexpr size_t WS_OD = 736 * MiB;
constexpr size_t WS_PB = 864 * MiB;
constexpr size_t WS_END = 896 * MiB;
constexpr int RING_OFF = 0, RING_BYTES = 131072;
constexpr int LDS_BYTES = 147456;

#define GAS __attribute__((address_space(1)))
#define LAS __attribute__((address_space(3)))
typedef unsigned short bf16;
typedef unsigned v4u __attribute__((ext_vector_type(4)));
typedef float f32x4 __attribute__((ext_vector_type(4)));
#define LDS_WAIT() asm volatile("s_waitcnt lgkmcnt(0)" ::: "memory")
__device__ __forceinline__ unsigned f2bf(float f) { unsigned u = __builtin_bit_cast(unsigned, f); return (u + 0x7fffu + ((u >> 16) & 1u)) >> 16; }
__device__ __forceinline__ unsigned pk2(float lo, float hi) { return f2bf(lo) | (f2bf(hi) << 16); }
__device__ __forceinline__ float bflo(unsigned u) { return __uint_as_float(u << 16); }
__device__ __forceinline__ float bfhi(unsigned u) { return __uint_as_float(u & 0xffff0000u); }

typedef GAS unsigned gu32;
#define RLX_AGENT __ATOMIC_RELAXED, __HIP_MEMORY_SCOPE_AGENT
#define XB_TMO      128
#define XB_XCNT(j)  (256  + 64 * (j))
#define XB_XSUB(j)  (1280 + 64 * (j))
#define XB_XGEN(j)  (2304 + 64 * (j))
#define XB_TOP      3328
#define XB_TOPGEN   3392
#define XCD_BAR_WORDS 3456
#define XB_SPIN_CAP (1u << 18)

__device__ __forceinline__ unsigned xb_ld(unsigned* p)              { return __hip_atomic_load(p, __ATOMIC_RELAXED, __HIP_MEMORY_SCOPE_AGENT); }
__device__ __forceinline__ unsigned xb_add(unsigned* p, unsigned v) { return __hip_atomic_fetch_add(p, v, __ATOMIC_RELAXED, __HIP_MEMORY_SCOPE_AGENT); }
__device__ __forceinline__ unsigned xb_xcc_id() { return (unsigned)__builtin_amdgcn_s_getreg((3 << 11) | 20) & 0xFu; }
#define XB_SPIN(cond, bar) do { unsigned _sp = 0; while (cond) { __builtin_amdgcn_s_sleep(1); \
    if ((++_sp & 255u) == 0u) { if (xb_ld(&(bar)[XB_TMO])) break; if (_sp > XB_SPIN_CAP) { atomicAdd(&(bar)[XB_TMO], 1u); break; } } } } while (0)

struct XcdBarrier {
    unsigned* bar; unsigned x;
    volatile LAS unsigned* st;
};

__device__ __forceinline__ XcdBarrier xcd_barrier_post(unsigned* bar, volatile LAS unsigned* st, const int tid_) {
    XcdBarrier b; b.bar = bar; b.x = xb_xcc_id(); b.st = st;
    if (tid_ == 0) (void)xb_add(&bar[XB_XCNT(b.x)], 1u);
    return b;
}
__device__ __forceinline__ void xcd_barrier_complete(unsigned* bar, unsigned x, unsigned& nloc, unsigned& nx) {
    const unsigned G = gridDim.x * gridDim.y * gridDim.z;
    unsigned sum, cnt, mine, sp = 0u;
    for (;;) {
        sum = 0u; cnt = 0u; mine = 0u;
#pragma unroll
        for (unsigned j = 0; j < 16; ++j) { const unsigned c = xb_ld(&bar[XB_XCNT(j)]); sum += c; cnt += (c > 0u) ? 1u : 0u; mine = (j == x) ? c : mine; }
        if (sum == G) break;
        __builtin_amdgcn_s_sleep(1);
        if ((++sp & 255u) == 0u) { if (xb_ld(&bar[XB_TMO])) break; if (sp > XB_SPIN_CAP) { atomicAdd(&bar[XB_TMO], 1u); break; } }
    }
    nloc = mine > 0u ? mine : 1u; nx = cnt > 0u ? cnt : 1u;
}

__device__ __forceinline__ void xcd_barrier(const XcdBarrier& b, const int tid_) {
    asm volatile("s_waitcnt vmcnt(0)" ::: "memory");
    __syncthreads();
    if (tid_ == 0) {
        unsigned* bar = b.bar;
        __builtin_amdgcn_s_waitcnt(0);
        unsigned nloc = b.st[0], nx = b.st[1];
        if (nloc == 0u) { xcd_barrier_complete(bar, b.x, nloc, nx); b.st[0] = nloc; b.st[1] = nx; }
        const unsigned old = xb_add(&bar[XB_XSUB(b.x)], 1u);
        const unsigned gen = old / nloc;
        if (old + 1u == (gen + 1u) * nloc) {
            __builtin_amdgcn_fence(__ATOMIC_RELEASE, "agent");
            asm volatile("s_waitcnt vmcnt(0)" ::: "memory");
            const unsigned og = xb_add(&bar[XB_TOP], 1u);
            const unsigned tg = og / nx;
            if (og + 1u == (tg + 1u) * nx) xb_add(&bar[XB_TOPGEN], 1u);
            else XB_SPIN(xb_ld(&bar[XB_TOPGEN]) == tg, bar);
            __builtin_amdgcn_fence(__ATOMIC_ACQUIRE, "agent");
            xb_add(&bar[XB_XGEN(b.x)], 1u);
            asm volatile("s_waitcnt vmcnt(0)" ::: "memory");
        } else {
            XB_SPIN(xb_ld(&bar[XB_XGEN(b.x)]) == gen, bar);
            __builtin_amdgcn_fence(__ATOMIC_ACQUIRE, "agent");
            asm volatile("s_waitcnt vmcnt(0)" ::: "memory");
        }
    }
    __syncthreads();
}

struct Frame {
    LAS unsigned char* lds;
    int tid, lane, wave, vcu, G;
    const float *x, *p, *w_in, *w_out, *g_mix, *lq1, *lk1, *lq2, *lk2, *g_subln, *w_ple, *w_gate, *g_ple, *g_final; float* out;
    bf16 *WinT, *WoutT, *WgT, *WpleT, *PROJB, *ZB, *HB, *PE, *XN, *OM, *OD, *PB;
    float *ROPE, *KMEAN, *PART, *PART2; unsigned* CNT;
};
__device__ __forceinline__ float wave_sum(float v) {
#pragma unroll
    for (int o = 1; o < 64; o <<= 1) v += __shfl_xor(v, o);
    return v;
}
__device__ __forceinline__ void p0_transpose_item(const float* W, int K, int N, bf16* WT, const float* kscale, LAS float* scr, int item, int lane, bool perm64 = false) {
    const int nblk = N / 32, kb = item / nblk, nb = item % nblk, k0 = 64 * kb, n0 = 32 * nb;
    const int n0w = perm64 ? (nb >> 3) * 256 + (nb & 1) * 128 + ((nb & 7) >> 1) * 32 : n0;
#pragma unroll 8
    for (int i = 0; i < 32; ++i) { const int kk = 2 * i + (lane >> 5); float w = W[(size_t)(k0 + kk) * N + n0 + (lane & 31)]; if (kscale) w *= kscale[k0 + kk]; scr[kk * 33 + (lane & 31)] = w; }
    LDS_WAIT(); asm volatile("" ::: "memory");
    const int c = lane & 7;
#pragma unroll
    for (int j = 0; j < 4; ++j) { const int n = (lane >> 3) + 8 * j; const LAS float* s = scr + (8 * c) * 33 + n;
        v4u o; o.x = pk2(s[0 * 33], s[1 * 33]); o.y = pk2(s[2 * 33], s[3 * 33]); o.z = pk2(s[4 * 33], s[5 * 33]); o.w = pk2(s[6 * 33], s[7 * 33]);
        *(GAS v4u*)(WT + (size_t)(n0w + n) * K + k0 + 8 * c) = o; }
    LDS_WAIT(); asm volatile("" ::: "memory");
}
__device__ __forceinline__ void p0_prologue(Frame& F) {
    LAS float* scr = (LAS float*)(F.lds + RING_OFF + F.wave * 16384);
    const int gw = F.vcu * NWAVES + F.wave, NGW = F.G * NWAVES;
    constexpr int I_IN = (D / 64) * (PROJ / 32), I_OUT = (D / 64) * (D / 32), I_G = I_OUT, I_PLE = (PLE / 64) * (D / 32);
    constexpr int NITEMS = I_IN + I_OUT + I_G + I_PLE;
    for (int it = gw; it < NITEMS; it += NGW) {
        int r = it;
        if (r < I_IN) { p0_transpose_item(F.w_in, D, PROJ, F.WinT, nullptr, scr, r, F.lane, true); continue; } r -= I_IN;
        if (r < I_OUT) { p0_transpose_item(F.w_out, D, D, F.WoutT, nullptr, scr, r, F.lane); continue; } r -= I_OUT;
        if (r < I_G) { p0_transpose_item(F.w_gate, D, D, F.WgT, F.g_ple, scr, r, F.lane); continue; } r -= I_G;
        p0_transpose_item(F.w_ple, PLE, D, F.WpleT, nullptr, scr, r, F.lane);
    }
    if (F.vcu == 0 && F.tid < 256) F.CNT[64 * F.tid] = 0u;
    { const int gt = F.vcu * (NWAVES * 64) + F.tid;
      if (gt < SEQ * 8) { const int pos = gt >> 3, j = gt & 7;
        const double inv = (j == 0) ? 0.15915494309189535 : (j == 1) ? 0.03086376340470123 : (j == 2) ? 0.005985185712713705 : (j == 3) ? 0.001160663641240061 : (j == 4) ? 0.00022507907903927653 : (j == 5) ? 4.364795279280289e-05 : (j == 6) ? 8.464330808241401e-06 : 1.6414262627950345e-06;
        double rev = (double)pos * inv; rev -= __builtin_rint(rev); const float rf = (float)rev;
        F.ROPE[pos * 16 + j] = __builtin_amdgcn_cosf(rf); F.ROPE[pos * 16 + 8 + j] = __builtin_amdgcn_sinf(rf); } }
    { f32x4 g[4];
#pragma unroll
      for (int j = 0; j < 4; ++j) g[j] = ((const GAS f32x4*)F.g_mix)[F.lane + 64 * j];
      for (int m0 = gw * 4; m0 < M; m0 += NGW * 4) {
        f32x4 v[4][4]; float s2[4];
#pragma unroll
        for (int r = 0; r < 4; ++r) { const GAS f32x4* xr = (const GAS f32x4*)(F.x + (size_t)(m0 + r) * D) + F.lane;
#pragma unroll
          for (int j = 0; j < 4; ++j) v[r][j] = __builtin_nontemporal_load(xr + 64 * j); }
#pragma unroll
        for (int r = 0; r < 4; ++r) { s2[r] = 0.f;
#pragma unroll
          for (int j = 0; j < 4; ++j) s2[r] += (v[r][j].x * v[r][j].x + v[r][j].y * v[r][j].y) + (v[r][j].z * v[r][j].z + v[r][j].w * v[r][j].w); }
#pragma unroll
        for (int o = 1; o < 64; o <<= 1) {
#pragma unroll
          for (int r = 0; r < 4; ++r) s2[r] += __shfl_xor(s2[r], o); }
#pragma unroll
        for (int r = 0; r < 4; ++r) { const float rs = 1.f / sqrtf(s2[r] * (1.f / D) + EPS);
          GAS unsigned long long* o8 = (GAS unsigned long long*)(F.XN + (size_t)(m0 + r) * D) + F.lane;
#pragma unroll
          for (int j = 0; j < 4; ++j) { const f32x4 w = v[r][j] * rs * g[j]; o8[64 * j] = (unsigned long long)pk2(w.x, w.y) | ((unsigned long long)pk2(w.z, w.w) << 32); } } } }
    { const size_t nthr = (size_t)F.G * NWAVES * 64; const size_t n8 = (size_t)M * PLE / 8;
      for (size_t i = (size_t)F.vcu * (NWAVES * 64) + F.tid; i < n8; i += nthr) { const f32x4 a = ((const GAS f32x4*)F.p)[2 * i], b = ((const GAS f32x4*)F.p)[2 * i + 1];
        v4u o; o.x = pk2(a.x, a.y); o.y = pk2(a.z, a.w); o.z = pk2(b.x, b.y); o.w = pk2(b.z, b.w); ((GAS v4u*)F.PB)[i] = o; } }
}
__device__ __forceinline__ void final_phase(Frame& F) {
    const int gw = F.vcu * NWAVES + F.wave, NGW = F.G * NWAVES;
    f32x4 g[4];
#pragma unroll
    for (int j = 0; j < 4; ++j) g[j] = ((const GAS f32x4*)F.g_final)[F.lane + 64 * j];
    for (int m0 = gw * 4; m0 < M; m0 += NGW * 4) {
        f32x4 v[4][4]; float s2[4];
#pragma unroll
        for (int r = 0; r < 4; ++r) { const GAS f32x4* xr = (const GAS f32x4*)(F.out + (size_t)(m0 + r) * D) + F.lane;
#pragma unroll
          for (int j = 0; j < 4; ++j) v[r][j] = xr[64 * j]; }
#pragma unroll
        for (int r = 0; r < 4; ++r) { s2[r] = 0.f;
#pragma unroll
          for (int j = 0; j < 4; ++j) s2[r] += (v[r][j].x * v[r][j].x + v[r][j].y * v[r][j].y) + (v[r][j].z * v[r][j].z + v[r][j].w * v[r][j].w); }
#pragma unroll
        for (int o = 1; o < 64; o <<= 1) {
#pragma unroll
          for (int r = 0; r < 4; ++r) s2[r] += __shfl_xor(s2[r], o); }
#pragma unroll
        for (int r = 0; r < 4; ++r) { const float rs = 1.f / sqrtf(s2[r] * (1.f / D) + EPS);
          GAS f32x4* xw = (GAS f32x4*)(F.out + (size_t)(m0 + r) * D) + F.lane;
#pragma unroll
          for (int j = 0; j < 4; ++j) __builtin_nontemporal_store(v[r][j] * rs * g[j], xw + 64 * j); }
    }
}

struct Args { const float* in[14]; float* out; unsigned char* ws; int ph_lo, ph_hi, cgsync, pad; };
__global__ void __launch_bounds__(NWAVES * 64, 2) mk_fwd(Args args) {
    extern __shared__ __attribute__((aligned(16))) unsigned char lds[];
    Frame F;
    F.lds = (LAS unsigned char*)lds;
    F.tid = threadIdx.x; F.lane = F.tid & 63; F.wave = __builtin_amdgcn_readfirstlane(F.tid >> 6);
    F.G = gridDim.x; { const int bx = blockIdx.x; F.vcu = (F.G % 8 == 0) ? (bx % 8) * (F.G / 8) + bx / 8 : bx; }
    unsigned char* ws = args.ws;
    F.x = args.in[0]; F.p = args.in[1]; F.w_in = args.in[2]; F.w_out = args.in[3]; F.g_mix = args.in[4]; F.lq1 = args.in[5]; F.lk1 = args.in[6]; F.lq2 = args.in[7]; F.lk2 = args.in[8];
    F.g_subln = args.in[9]; F.w_ple = args.in[10]; F.w_gate = args.in[11]; F.g_ple = args.in[12]; F.g_final = args.in[13]; F.out = args.out;
    F.WinT = (bf16*)(ws + WS_WIN); F.WoutT = (bf16*)(ws + WS_WOUT); F.WgT = (bf16*)(ws + WS_WG); F.WpleT = (bf16*)(ws + WS_WPLE);
    F.PROJB = (bf16*)(ws + WS_PROJ); F.ZB = (bf16*)(ws + WS_Z); F.HB = (bf16*)(ws + WS_HB); F.PE = (bf16*)(ws + WS_PE); F.XN = (bf16*)(ws + WS_XN); F.OM = (bf16*)(ws + WS_OM); F.OD = (bf16*)(ws + WS_OD); F.PB = (bf16*)(ws + WS_PB);
    F.ROPE = (float*)(ws + WS_ROPE); F.KMEAN = (float*)(ws + WS_KMEAN); F.PART = (float*)(ws + WS_PART); F.PART2 = (float*)(ws + WS_PART2); F.CNT = (unsigned*)(ws + WS_CNT);
    const int lo = args.ph_lo, hi = args.ph_hi;
    volatile LAS unsigned* MISC = (volatile LAS unsigned*)(F.lds + RING_BYTES + 320);
    if (F.tid < 32) MISC[F.tid] = 0u;
    __syncthreads();
    XcdBarrier bar = xcd_barrier_post((unsigned*)ws, MISC + 8, F.tid);
#ifndef REP_PHASE
#define REP_PHASE -1
#endif
#define NREP(k) (((k) == REP_PHASE) ? 2 : 1)
#ifndef PHMASK
#define PHMASK 0xff
#endif
#define IN(k) (((PHMASK >> (k)) & 1) && lo <= (k) && (k) < hi)
#define GRIDBAR() do { if (args.cgsync) cg::this_grid().sync(); else xcd_barrier(bar, tid_now(F.wave)); } while (0)
#define SEAM3B do { if (IN(3) && IN(5)) { GRIDBAR(); } } while (0)
#define SEAM(k) do { if (IN(k) && IN((k) + 1)) { GRIDBAR(); } } while (0)

    if (IN(0)) { for (int rp = 0; rp < NREP(0); ++rp) p0_prologue(F); }
    SEAM(0);
    if (IN(1)) {
        pg8::Gemm g{F.XN, F.WinT, M, PROJ, D}; pg8::StaticOrder S; S.init(M, PROJ, F.G, (int)blockIdx.x);
        pg8::EpiProj E{F.PROJB, F.ZB, F.ROPE, F.KMEAN};
        pg8::gemm_phase<pg8::EpiProj, pg8::StaticOrder, PG8_ALIGN, PG8_SP2>(F.lds + RING_OFF, g, S, E, F.wave);
    }
    if (IN(1) && NREP(1) == 2) {
        pg8::Gemm g{F.XN, F.WinT, M, PROJ, D}; pg8::StaticOrder S; S.init(M, PROJ, F.G, (int)blockIdx.x);
        pg8::EpiProj E{F.PROJB, F.ZB, F.ROPE, F.KMEAN};
        pg8::gemm_phase<pg8::EpiProj, pg8::StaticOrder, PG8_ALIGN, PG8_SP2>(F.lds + RING_OFF, g, S, E, F.wave);
    }
    if (IN(1) && IN(3)) { GRIDBAR(); }
    if (IN(3)) for (int rp = 0; rp < NREP(3); ++rp) {
        const attn_body::AttnArgs AT{(const attn_body::bf16*)F.PROJB, (const attn_body::bf16*)F.ZB, (attn_body::bf16*)F.XN, (attn_body::bf16*)F.OD, F.KMEAN, F.g_subln, F.lq1, F.lk1, F.lq2, F.lk2};
        attn_body::attn_phase<8>((char*)lds + RING_OFF, AT, F.vcu, F.G, F.wave);
    }
    SEAM3B;
    if (IN(5)) {
        { pg8::Gemm g{F.XN, F.WoutT, M, D, D}; pg8::StaticOrder S; S.init(M, D, F.G, (int)blockIdx.x);
          pg8::EpiOut E{F.x, F.HB, F.PART};
          pg8::gemm_phase<pg8::EpiOut, pg8::StaticOrder, PG8_ALIGN, PG8_SP2>(F.lds + RING_OFF, g, S, E, F.wave); }
        { int kple = PLE; asm volatile("" : "+s"(kple));
          pg8::Gemm g{F.PB, F.WpleT, M, D, kple}; pg8::StaticOrder S; S.init(M, D, F.G, (int)blockIdx.x);
          pg8::EpiBf16<0> E{F.PE, D, nullptr, 0, 0, 1.f};
          pg8::gemm_phase<pg8::EpiBf16<0>, pg8::StaticOrder, PG8_ALIGN, PG8_SP2>(F.lds + RING_OFF, g, S, E, F.wave); }
    }
    if (IN(5) && NREP(5) == 2) {
        { pg8::Gemm g{F.XN, F.WoutT, M, D, D}; pg8::StaticOrder S; S.init(M, D, F.G, (int)blockIdx.x);
          pg8::EpiOut E{F.x, F.HB, F.PART};
          pg8::gemm_phase<pg8::EpiOut, pg8::StaticOrder, PG8_ALIGN, PG8_SP2>(F.lds + RING_OFF, g, S, E, F.wave); }
        { int kple = PLE; asm volatile("" : "+s"(kple));
          pg8::Gemm g{F.PB, F.WpleT, M, D, kple}; pg8::StaticOrder S; S.init(M, D, F.G, (int)blockIdx.x);
          pg8::EpiBf16<0> E{F.PE, D, nullptr, 0, 0, 1.f};
          pg8::gemm_phase<pg8::EpiBf16<0>, pg8::StaticOrder, PG8_ALIGN, PG8_SP2>(F.lds + RING_OFF, g, S, E, F.wave); }
    }
    SEAM(5);
    if (IN(6)) {
        pg8::Gemm g{F.HB, F.WgT, M, D, D}; pg8::StaticOrder S; S.init(M, D, F.G, (int)blockIdx.x);
        pg8::EpiGate E{F.HB, F.PE, F.out, F.PART, F.PART2, F.CNT, F.g_final};
        pg8::gemm_phase<pg8::EpiGate, pg8::StaticOrder, PG8_ALIGN, PG8_SP2>(F.lds + RING_OFF, g, S, E, F.wave);
    }
#undef IN
#undef SEAM
}

extern "C" void kernel_launch(void* const* d_in, const int* in_sizes, int n_in, void* d_out, int out_size, void* d_ws, size_t ws_size, hipStream_t stream) {
    static int grid = 0;
    if (grid == 0) {
        if (n_in != 14 || in_sizes[0] != M * D || out_size != M * D || ws_size < WS_END) { fprintf(stderr, "kernel_launch: shape/workspace mismatch: n_in %d, in0 %d, out %d, ws %zu (need %zu)\n", n_in, n_in > 0 ? in_sizes[0] : -1, out_size, ws_size, (size_t)WS_END); grid = -1; return; }
        int dev = 0, cus = 0, per_cu = 0;
        if (hipGetDevice(&dev) != hipSuccess || hipDeviceGetAttribute(&cus, hipDeviceAttributeMultiprocessorCount, dev) != hipSuccess) { fprintf(stderr, "kernel_launch: device query failed\n"); grid = -1; return; }
        if (hipFuncSetAttribute((const void*)mk_fwd, hipFuncAttributeMaxDynamicSharedMemorySize, LDS_BYTES) != hipSuccess) { fprintf(stderr, "kernel_launch: hipFuncSetAttribute failed\n"); grid = -1; return; }
        if (hipOccupancyMaxActiveBlocksPerMultiprocessor(&per_cu, (const void*)mk_fwd, NWAVES * 64, LDS_BYTES) != hipSuccess || per_cu < 1) { fprintf(stderr, "kernel_launch: occupancy query reports %d\n", per_cu); per_cu = 1; }
        (void)hipGetLastError();
        grid = cus;
    }
    if (grid < 0) return;
    if (hipMemsetAsync(d_ws, 0, 65536, stream) != hipSuccess) { fprintf(stderr, "kernel_launch: hipMemsetAsync failed\n"); return; }
    Args a{};
    for (int i = 0; i < 14; ++i) a.in[i] = (const float*)d_in[i];
    a.out = (float*)d_out; a.ws = (unsigned char*)d_ws;
    if (N_LAUNCHES == 1) {
        a.ph_lo = 0; a.ph_hi = N_PHASES;
        void* kargs[] = {&a};
        const hipError_t le = hipLaunchCooperativeKernel((const void*)mk_fwd, dim3(grid), dim3(NWAVES * 64), kargs, LDS_BYTES, stream);
        if (le != hipSuccess) fprintf(stderr, "kernel_launch: cooperative launch failed: %s (grid %d)\n", hipGetErrorString(le), grid);
    } else {
        for (int li = 0; li < N_PHASES; ++li) {
            a.ph_lo = li; a.ph_hi = li + 1;
            hipLaunchKernelGGL(mk_fwd, dim3(grid), dim3(NWAVES * 64), LDS_BYTES, stream, a);
            const hipError_t le = hipPeekAtLastError();
            if (le != hipSuccess) { fprintf(stderr, "kernel_launch: launch %d failed: %s\n", li, hipGetErrorName(le)); break; }
        }
    }
}
```
